# Optimizing an MI355X kernel written in HIP

```python
import math
import jax, jax.numpy as jnp
from jax import lax
import numpy as np

D_MODEL = 1024
BATCH = 8
SEQ = 8192
DEPTH = 2
DEC_BATCH = 4
DEC_SEQ = 4096
PAST_LEN = 128

RW_HEADS = 4
RW_HEAD = 64
RW_W = RW_HEADS * RW_HEAD
RW_LORA_W = 32
RW_LORA_A = 32
RW_LORA_G = 64
RW_GN_EPS = 64e-5
MLA_HEADS = 8
MLA_NOPE = 64
MLA_ROPE = 32
MLA_V = 64
MLA_Q_LORA = 256
MLA_KV_LORA = 128
MLA_W = MLA_HEADS * MLA_V
MLA_SCALE = (MLA_NOPE + MLA_ROPE) ** -0.5
ROPE_THETA = 10000.0
Q_BLOCK = 128
RMS_EPS = 1e-6
S5_W = 256
S5_GROUP = 16
S5_GROUPS = S5_W // S5_GROUP
S5_STATE = 64
D_FF = 4 * D_MODEL
LN_EPS = 1e-5
N_BRANCH = 3
DN_ALPHA = (2 * DEPTH) ** 0.25
DN_BETA = (8 * DEPTH) ** -0.25
RW_SHIFT_W = 3 * RW_W + RW_LORA_W + RW_LORA_A + RW_LORA_G
MLA_IN_W = MLA_Q_LORA + MLA_KV_LORA + MLA_ROPE
OFF_MLA = RW_SHIFT_W
OFF_S5 = OFF_MLA + MLA_IN_W
OFF_GATE = OFF_S5 + S5_W
D_IN = OFF_GATE + N_BRANCH * D_MODEL

kernel_name = 'hybrid_rwkv7_mla_s5_encoder'


def _layer_norm(x, g, b):
    xf = x.astype(jnp.float32)
    mu = jnp.mean(xf, -1, keepdims=True)
    var = jnp.mean(jnp.square(xf - mu), -1, keepdims=True)
    return ((xf - mu) * lax.rsqrt(var + LN_EPS) * g.astype(jnp.float32) + b.astype(jnp.float32)).astype(x.dtype)


def _rms_norm(x, g):
    xf = x.astype(jnp.float32)
    return (xf * lax.rsqrt(jnp.mean(xf * xf, -1, keepdims=True) + RMS_EPS) * g.astype(jnp.float32)).astype(x.dtype)


def _centred_shift(z):
    zp = jnp.pad(z, ((0, 0), (1, 1), (0, 0)))
    return 0.5 * (zp[:, :-2] + zp[:, 2:])


def _rwkv_scan(r, w, kk, a, k, v, reverse):
    bsz, h, n = r.shape[1:]

    def step(S, inp):
        r_t, w_t, kk_t, a_t, k_t, v_t = inp
        sa = jnp.einsum('bhij,bhj->bhi', S, kk_t)
        S = (S * w_t[:, :, None, :]
             - sa[..., None] * (kk_t * a_t)[:, :, None, :]
             + v_t[..., None] * k_t[:, :, None, :])
        return S, jnp.einsum('bhij,bhj->bhi', S, r_t)

    S0 = jnp.zeros((bsz, h, n, n), jnp.float32)
    _, o = lax.scan(step, S0, (r, w, kk, a, k, v), reverse=reverse)
    return o


def _rwkv_mixer(z, mu, w0, w2, a0, a2, g2, k_k, k_a, r_k, gn_g, gn_b):
    f32 = jnp.float32
    bsz, seq, _ = z.shape
    z = z + mu * (_centred_shift(z) - z)
    r = z[..., 0:RW_W]
    k = z[..., RW_W:2 * RW_W]
    v = z[..., 2 * RW_W:3 * RW_W]
    xw = z[..., 3 * RW_W:3 * RW_W + RW_LORA_W]
    xa = z[..., 3 * RW_W + RW_LORA_W:3 * RW_W + RW_LORA_W + RW_LORA_A]
    xg = z[..., 3 * RW_W + RW_LORA_W + RW_LORA_A:]

    def heads(t):
        return t.astype(f32).reshape(bsz, seq, RW_HEADS, RW_HEAD)

    def time_major(t):
        return heads(t).transpose(1, 0, 2, 3)

    kk = heads(k * k_k)
    kk = kk * lax.rsqrt(jnp.maximum(jnp.sum(kk * kk, -1, keepdims=True), 1e-12))
    kk_t = kk.transpose(1, 0, 2, 3)
    r_t = time_major(r)
    v_t = time_major(v)
    o = jnp.zeros((seq, bsz, RW_HEADS, RW_HEAD), f32)
    for d in range(2):
        w_log = -jax.nn.softplus(-(w0[d] + jnp.tanh(xw) @ w2[d]).astype(f32)) - 0.5
        decay = jnp.exp(-jnp.exp(w_log))
        a = jax.nn.sigmoid((a0[d] + xa @ a2[d]).astype(f32))
        k_d = k.astype(f32) * (1.0 + (a - 1.0) * k_a.astype(f32))
        o = o + _rwkv_scan(r_t, time_major(decay), kk_t, time_major(a), time_major(k_d), v_t, d == 1)
    o = o.transpose(1, 0, 2, 3)
    mean = jnp.mean(o, -1, keepdims=True)
    var = jnp.mean(jnp.square(o - mean), -1, keepdims=True)
    o = ((o - mean) * lax.rsqrt(var + RW_GN_EPS)).reshape(bsz, seq, RW_W) * gn_g.astype(f32) + gn_b.astype(f32)
    bonus = jnp.sum(heads(r) * heads(k) * r_k.astype(f32).reshape(RW_HEADS, RW_HEAD), -1, keepdims=True) * heads(v)
    g = (jax.nn.sigmoid(xg) @ g2).astype(f32)
    return ((o + bonus.reshape(bsz, seq, RW_W)) * g).astype(z.dtype)


def _rope(t, seq):
    f32 = jnp.float32
    half = MLA_ROPE // 2
    inv = ROPE_THETA ** (-jnp.arange(half, dtype=f32) / half)
    ang = jnp.arange(seq, dtype=f32)[:, None] * inv[None, :]
    shape = (1, seq) + (1,) * (t.ndim - 3) + (half,)
    cos = jnp.cos(ang).reshape(shape)
    sin = jnp.sin(ang).reshape(shape)
    tf = t.astype(f32)
    t1, t2 = tf[..., :half], tf[..., half:]
    return jnp.concatenate([t1 * cos - t2 * sin, t1 * sin + t2 * cos], -1).astype(t.dtype)


def _mla_mixer(z, q_norm, w_uq, kv_norm, w_ukv):
    f32 = jnp.float32
    bsz, seq, _ = z.shape
    c_q = z[..., :MLA_Q_LORA]
    c_kv = z[..., MLA_Q_LORA:MLA_Q_LORA + MLA_KV_LORA]
    k_rope = _rope(z[..., MLA_Q_LORA + MLA_KV_LORA:], seq)
    q = (_rms_norm(c_q, q_norm) @ w_uq).reshape(bsz, seq, MLA_HEADS, MLA_NOPE + MLA_ROPE)
    kv = (_rms_norm(c_kv, kv_norm) @ w_ukv).reshape(bsz, seq, MLA_HEADS, MLA_NOPE + MLA_V)
    q_nope = q[..., :MLA_NOPE]
    q_rope = _rope(q[..., MLA_NOPE:], seq)
    k_nope = kv[..., :MLA_NOPE]
    v = kv[..., MLA_NOPE:]
    n_blk = seq // Q_BLOCK

    def blocks(t):
        return t.reshape((bsz, n_blk, Q_BLOCK) + t.shape[2:]).swapaxes(0, 1)

    def attend(qs):
        qn, qr = qs
        s = (jnp.einsum('bqhd,bkhd->bhqk', qn, k_nope)
             + jnp.einsum('bqhr,bkr->bhqk', qr, k_rope)).astype(f32) * MLA_SCALE
        p = jax.nn.softmax(s, axis=-1).astype(v.dtype)
        return jnp.einsum('bhqk,bkhd->bqhd', p, v)

    o = lax.map(attend, (blocks(q_nope), blocks(q_rope)))
    return o.swapaxes(0, 1).reshape(bsz, seq, MLA_W)


def _s5_direction(u, lam_re, lam_im, log_dt, b_re, b_im, c_re, c_im, reverse):
    dt = jnp.exp(log_dt)[:, None]
    mag = jnp.exp(lam_re * dt)
    ab_re = mag * jnp.cos(lam_im * dt)
    ab_im = mag * jnp.sin(lam_im * dt)
    den = lam_re * lam_re + lam_im * lam_im
    nr = ab_re - 1.0
    ni = ab_im
    coef_re = (nr * lam_re + ni * lam_im) / den
    coef_im = (ni * lam_re - nr * lam_im) / den
    bb_re = coef_re[..., None] * b_re - coef_im[..., None] * b_im
    bb_im = coef_re[..., None] * b_im + coef_im[..., None] * b_re
    bu_re = jnp.einsum('blgc,gpc->blgp', u, bb_re)
    bu_im = jnp.einsum('blgc,gpc->blgp', u, bb_im)
    a_re = jnp.broadcast_to(ab_re, bu_re.shape)
    a_im = jnp.broadcast_to(ab_im, bu_re.shape)

    def combine(e1, e2):
        a1r, a1i, b1r, b1i = e1
        a2r, a2i, b2r, b2i = e2
        return (a2r * a1r - a2i * a1i,
                a2r * a1i + a2i * a1r,
                a2r * b1r - a2i * b1i + b2r,
                a2r * b1i + a2i * b1r + b2i)

    _, _, x_re, x_im = lax.associative_scan(combine, (a_re, a_im, bu_re, bu_im), reverse=reverse, axis=1)
    return jnp.einsum('blgp,gcp->blgc', x_re, c_re) - jnp.einsum('blgp,gcp->blgc', x_im, c_im)


def _s5_mixer(u, lam_re, lam_im, log_dt, b_re, b_im, c_re, c_im, d_skip, glu_w, glu_b):
    f32 = jnp.float32
    bsz, seq, _ = u.shape
    uf = u.astype(f32)
    ug = uf.reshape(bsz, seq, S5_GROUPS, S5_GROUP)
    y = jnp.zeros_like(ug)
    for d in range(2):
        y = y + _s5_direction(ug, lam_re[d].astype(f32), lam_im[d].astype(f32), log_dt[d].astype(f32),
                              b_re[d].astype(f32), b_im[d].astype(f32),
                              c_re[d].astype(f32), c_im[d].astype(f32), d == 1)
    y = y.reshape(bsz, seq, S5_W) + d_skip.astype(f32) * uf
    y = jax.nn.gelu(y).astype(u.dtype)
    return y * jax.nn.sigmoid(y @ glu_w + glu_b)


def _layer(x, w_in, rw_mu, rw_w0, rw_w2, rw_a0, rw_a2, rw_g2, rw_k_k, rw_k_a, rw_r_k, rw_gn_g, rw_gn_b, rw_proj,
           mla_q_norm, mla_w_uq, mla_kv_norm, mla_w_ukv, mla_proj,
           s5_lam_re, s5_lam_im, s5_log_dt, s5_b_re, s5_b_im, s5_c_re, s5_c_im, s5_d, s5_glu_w, s5_glu_b, s5_proj,
           w_out, ln1_g, ln1_b, mlp_w1, mlp_w2, ln2_g, ln2_b):
    bsz, seq, _ = x.shape
    z = x @ w_in
    y_rw = _rwkv_mixer(z[..., :OFF_MLA], rw_mu, rw_w0, rw_w2, rw_a0, rw_a2, rw_g2,
                       rw_k_k, rw_k_a, rw_r_k, rw_gn_g, rw_gn_b) @ rw_proj
    y_mla = _mla_mixer(z[..., OFF_MLA:OFF_S5], mla_q_norm, mla_w_uq, mla_kv_norm, mla_w_ukv) @ mla_proj
    y_s5 = _s5_mixer(z[..., OFF_S5:OFF_GATE], s5_lam_re, s5_lam_im, s5_log_dt, s5_b_re, s5_b_im,
                     s5_c_re, s5_c_im, s5_d, s5_glu_w, s5_glu_b) @ s5_proj
    gates = jax.nn.sigmoid(z[..., OFF_GATE:].astype(jnp.float32)).astype(x.dtype)
    gates = gates.reshape(bsz, seq, N_BRANCH, D_MODEL)
    merged = gates[:, :, 0] * y_rw + gates[:, :, 1] * y_mla + gates[:, :, 2] * y_s5
    x = _layer_norm(DN_ALPHA * x + merged @ w_out, ln1_g, ln1_b)
    h = jnp.square(jax.nn.relu(x @ mlp_w1))
    return _layer_norm(DN_ALPHA * x + h @ mlp_w2, ln2_g, ln2_b)


def _trunk(x, weights):
    for l in range(DEPTH):
        x = _layer(x, *[w[l] for w in weights])
    return x


def setup_inputs(seed: int = 0) -> dict:
    key = jax.random.key(seed)
    ks = iter(jax.random.split(key, 48))
    f32 = jnp.float32

    def nrm(shape, scale):
        return scale * jax.random.normal(next(ks), shape, f32)

    decay_base = jnp.broadcast_to(jnp.linspace(-6.0, -1.0, RW_HEAD, dtype=f32), (RW_HEADS, RW_HEAD)).reshape(RW_W)
    lam_im_base = jnp.pi * jnp.arange(S5_STATE, dtype=f32)
    return {
        'x_prompt': nrm((BATCH, SEQ, D_MODEL), 1.0),
        'x_sample': nrm((DEC_BATCH, DEC_SEQ, D_MODEL), 1.0),
        'w_in': nrm((DEPTH, D_MODEL, D_IN), D_MODEL ** -0.5),
        'rw_mu': jax.random.uniform(next(ks), (DEPTH, RW_SHIFT_W), f32),
        'rw_w0': decay_base + nrm((DEPTH, 2, RW_W), 0.1),
        'rw_w2': nrm((DEPTH, 2, RW_LORA_W, RW_W), 0.1),
        'rw_a0': nrm((DEPTH, 2, RW_W), 0.1),
        'rw_a2': nrm((DEPTH, 2, RW_LORA_A, RW_W), 0.5 * RW_LORA_A ** -0.5),
        'rw_g2': nrm((DEPTH, RW_LORA_G, RW_W), RW_LORA_G ** -0.5),
        'rw_k_k': 0.85 + nrm((DEPTH, RW_W), 0.05),
        'rw_k_a': 1.0 + nrm((DEPTH, RW_W), 0.05),
        'rw_r_k': nrm((DEPTH, RW_W), 0.1),
        'rw_gn_g': 1.0 + nrm((DEPTH, RW_W), 0.05),
        'rw_gn_b': nrm((DEPTH, RW_W), 0.02),
        'rw_proj': nrm((DEPTH, RW_W, D_MODEL), RW_W ** -0.5),
        'mla_q_norm': 1.0 + nrm((DEPTH, MLA_Q_LORA), 0.05),
        'mla_w_uq': nrm((DEPTH, MLA_Q_LORA, MLA_HEADS * (MLA_NOPE + MLA_ROPE)), MLA_Q_LORA ** -0.5),
        'mla_kv_norm': 1.0 + nrm((DEPTH, MLA_KV_LORA), 0.05),
        'mla_w_ukv': nrm((DEPTH, MLA_KV_LORA, MLA_HEADS * (MLA_NOPE + MLA_V)), MLA_KV_LORA ** -0.5),
        'mla_proj': nrm((DEPTH, MLA_W, D_MODEL), MLA_W ** -0.5),
        's5_lam_re': -0.5 + nrm((DEPTH, 2, S5_GROUPS, S5_STATE), 0.01),
        's5_lam_im': lam_im_base + nrm((DEPTH, 2, S5_GROUPS, S5_STATE), 0.01),
        's5_log_dt': jax.random.uniform(next(ks), (DEPTH, 2, S5_GROUPS), f32,
                                        minval=math.log(1e-3), maxval=math.log(1e-1)),
        's5_b_re': nrm((DEPTH, 2, S5_GROUPS, S5_STATE, S5_GROUP), (2 * S5_GROUP) ** -0.5),
        's5_b_im': nrm((DEPTH, 2, S5_GROUPS, S5_STATE, S5_GROUP), (2 * S5_GROUP) ** -0.5),
        's5_c_re': nrm((DEPTH, 2, S5_GROUPS, S5_GROUP, S5_STATE), S5_STATE ** -0.5),
        's5_c_im': nrm((DEPTH, 2, S5_GROUPS, S5_GROUP, S5_STATE), S5_STATE ** -0.5),
        's5_d': nrm((DEPTH, S5_W), 1.0),
        's5_glu_w': nrm((DEPTH, S5_W, S5_W), S5_W ** -0.5),
        's5_glu_b': nrm((DEPTH, S5_W), 0.02),
        's5_proj': nrm((DEPTH, S5_W, D_MODEL), S5_W ** -0.5),
        'w_out': nrm((DEPTH, D_MODEL, D_MODEL), DN_BETA * D_MODEL ** -0.5),
        'ln1_g': 1.0 + nrm((DEPTH, D_MODEL), 0.05),
        'ln1_b': nrm((DEPTH, D_MODEL), 0.02),
        'mlp_w1': nrm((DEPTH, D_MODEL, D_FF), D_MODEL ** -0.5),
        'mlp_w2': nrm((DEPTH, D_FF, D_MODEL), DN_BETA * D_FF ** -0.5),
        'ln2_g': 1.0 + nrm((DEPTH, D_MODEL), 0.05),
        'ln2_b': nrm((DEPTH, D_MODEL), 0.02),
    }


def reference(x_prompt, x_sample, w_in, rw_mu, rw_w0, rw_w2, rw_a0, rw_a2, rw_g2, rw_k_k, rw_k_a, rw_r_k,
              rw_gn_g, rw_gn_b, rw_proj, mla_q_norm, mla_w_uq, mla_kv_norm, mla_w_ukv, mla_proj,
              s5_lam_re, s5_lam_im, s5_log_dt, s5_b_re, s5_b_im, s5_c_re, s5_c_im, s5_d, s5_glu_w, s5_glu_b,
              s5_proj, w_out, ln1_g, ln1_b, mlp_w1, mlp_w2, ln2_g, ln2_b):
    weights = (w_in, rw_mu, rw_w0, rw_w2, rw_a0, rw_a2, rw_g2, rw_k_k, rw_k_a, rw_r_k, rw_gn_g, rw_gn_b, rw_proj,
               mla_q_norm, mla_w_uq, mla_kv_norm, mla_w_ukv, mla_proj,
               s5_lam_re, s5_lam_im, s5_log_dt, s5_b_re, s5_b_im, s5_c_re, s5_c_im, s5_d, s5_glu_w, s5_glu_b,
               s5_proj, w_out, ln1_g, ln1_b, mlp_w1, mlp_w2, ln2_g, ln2_b)
    y_prompt = _trunk(x_prompt, weights)
    y_sample = _trunk(x_sample, weights)
    return (y_prompt, y_sample)
```

```cpp
#include <hip/hip_runtime.h>
#include <hip/hip_cooperative_groups.h>
#include <hip/hip_fp16.h>
#include <cstdio>
#include <cstdint>
namespace cg = cooperative_groups;

#ifndef ONE_LAUNCH
#define ONE_LAUNCH 1
#endif

#ifndef SCANVAR
#define SCANVAR 0
#endif
typedef unsigned short u16;
typedef short bf16x8 __attribute__((ext_vector_type(8)));
typedef float f32x4 __attribute__((ext_vector_type(4)));
typedef unsigned u32x4 __attribute__((ext_vector_type(4)));
typedef unsigned u32x2 __attribute__((ext_vector_type(2)));
typedef float f32x2 __attribute__((ext_vector_type(2)));
#define DEV __device__ __forceinline__

constexpr int T_TOK = 81920;
constexpr int T_PROMPT = 65536;
constexpr float DN_ALPHA = 1.41421356237f;
constexpr int LDS_BYTES = 74752;

constexpr size_t OFF_CTR  = 0;
constexpr size_t OFF_ROPE = 65536;
constexpr size_t OFF_S5A  = OFF_ROPE + 1048576;
constexpr size_t OFF_S5BB = OFF_S5A + 32768;
constexpr size_t OFF_S5E  = OFF_S5BB + 524288;
constexpr size_t OFF_W    = OFF_S5E + 5242880;
constexpr size_t WL_ELEMS = 15728640;
constexpr size_t OFF_XB   = OFF_W + 2 * WL_ELEMS * 2;
constexpr size_t OFF_ZRW  = OFF_XB + (size_t)T_TOK * 1024 * 2;
constexpr size_t OFF_ZMLA = OFF_ZRW + (size_t)T_TOK * 896 * 2;
constexpr size_t OFF_YG   = OFF_ZMLA;
constexpr size_t OFF_ZS5  = OFF_ZMLA + (size_t)T_TOK * 416 * 2;
constexpr size_t OFF_Q    = OFF_ZS5 + (size_t)T_TOK * 256 * 2;
constexpr size_t OFF_MRG  = OFF_Q;
constexpr size_t OFF_K    = OFF_Q + (size_t)T_TOK * 768 * 2;
constexpr size_t OFF_KR   = OFF_K + (size_t)T_TOK * 512 * 2;
constexpr size_t OFF_VT   = OFF_KR + (size_t)T_TOK * 32 * 2;
constexpr size_t OFF_OCAT = OFF_VT + (size_t)T_TOK * 512 * 2;
constexpr size_t OFF_OFB  = OFF_OCAT + (size_t)T_TOK * 1024 * 2;
constexpr size_t OFF_END  = OFF_OFB + (size_t)2 * T_TOK * 256 * 2;
constexpr size_t OFF_H    = OFF_ZRW;
constexpr size_t W_WIN = 0, W_WG = 1703936, W_RWP = 4849664, W_MLAP = 5111808, W_S5P = 5636096, W_WOUT = 5898240,
                 W_W1 = 6946816, W_W2 = 11141120, W_WUQ = 15335424, W_WUKV = 15532032, W_GLU = 15663104;

struct Params { const float* in[38]; float* out; char* ws; };
__device__ __forceinline__ int TID() { int t = threadIdx.x; asm volatile("" : "+v"(t)); return t; }
typedef char __attribute__((address_space(1))) gchar_t;
typedef float __attribute__((address_space(1))) gfloat_t;
__device__ __forceinline__ char* WS(const Params& p) { gchar_t* w = (gchar_t*)p.ws; asm volatile("" : "+s"(w)); return (char*)w; }
__device__ __forceinline__ float* OUTP(const Params& p) { gfloat_t* w = (gfloat_t*)p.out; asm volatile("" : "+s"(w)); return (float*)w; }

DEV float bf2f(u16 h) { return __uint_as_float(((unsigned)h) << 16); }
typedef __bf16 bf16_2 __attribute__((ext_vector_type(2)));
DEV unsigned pack2(float a, float b) { bf16_2 v; v[0] = (__bf16)a; v[1] = (__bf16)b; return __builtin_bit_cast(unsigned, v); }
DEV u16 f2bf(float f) { return __builtin_bit_cast(u16, (__bf16)f); }
template <int CTRL> DEV float dppf(float v) { return __int_as_float(__builtin_amdgcn_update_dpp(0, __float_as_int(v), CTRL, 0xf, 0xf, false)); }
DEV float xsum16(float v) { auto r = __builtin_amdgcn_permlane16_swap(__float_as_uint(v), __float_as_uint(v), false, false); return __uint_as_float(r[0]) + __uint_as_float(r[1]); }
DEV float xsum32(float v) { auto r = __builtin_amdgcn_permlane32_swap(__float_as_uint(v), __float_as_uint(v), false, false); return __uint_as_float(r[0]) + __uint_as_float(r[1]); }
DEV float wave_sum(float v) {
    v += dppf<0xB1>(v); v += dppf<0x4E>(v); v += dppf<0x141>(v); v += dppf<0x140>(v);
    v = xsum16(v); v = xsum32(v);
    return v;
}
DEV float sigm(float x) { return __builtin_amdgcn_rcpf(1.f + __expf(-x)); }
DEV int tok_pos(int t) { return t < T_PROMPT ? (t & 8191) : (t & 4095); }
DEV int tok_len(int t) { return t < T_PROMPT ? 8192 : 4096; }

DEV void lds_barrier() { asm volatile("s_waitcnt lgkmcnt(0)\n\ts_barrier" ::: "memory"); }
template <int MT, int NT, bool ROWSS, bool TR>
DEV void gemm_acc(f32x4 (&acc)[MT][NT], const u16* __restrict__ A, int lda, const u16* __restrict__ Bt, int ldb, int K,
                  char* lds, float* ss_lds) {
    constexpr int BM = 32 * MT, BN = 32 * NT, PITCH = 128, STAGE = (BM + BN) * PITCH;
    const int tid = TID(), lane = tid & 63, wid = tid >> 6, wr = wid >> 1, wc = wid & 1, fr = lane & 15, g = lane >> 4;
    const int lrow = tid >> 3, lch = tid & 7;
    u32x4 ra0[MT], rb0[NT], ra1[MT], rb1[NT];
    float ss[MT];
#pragma unroll
    for (int i = 0; i < MT; ++i) ss[i] = 0.f;
    const u16* Ap = A + (size_t)lrow * lda + lch * 8;
    const u16* Bp = Bt + (size_t)lrow * ldb + lch * 8;
    const int nk = K >> 6;
    char* const wA = lds + lrow * PITCH + ((lch ^ ((lrow >> 1) & 7)) * 16);
    char* const wB = wA + BM * PITCH;
    const int rc0 = (g ^ (fr >> 1)) * 16, rc1 = ((4 + g) ^ (fr >> 1)) * 16;
    const char* const rA = lds + (wr * MT * 16 + fr) * PITCH;
    const char* const rB = lds + BM * PITCH + (wc * NT * 16 + fr) * PITCH;
#define GA_LOAD(RA, RB, KT) do { const int k0_ = (KT) * 64; \
        _Pragma("unroll") for (int i = 0; i < MT; ++i) RA[i] = *(const u32x4*)(Ap + (size_t)(32 * i) * lda + k0_); \
        _Pragma("unroll") for (int i = 0; i < NT; ++i) RB[i] = *(const u32x4*)(Bp + (size_t)(32 * i) * ldb + k0_); } while (0)
#define GA_STORE(RA, RB, ST) do { \
        _Pragma("unroll") for (int i = 0; i < MT; ++i) { *(u32x4*)(wA + (ST) * STAGE + (32 * i) * PITCH) = RA[i]; \
            if (ROWSS) { _Pragma("unroll") for (int q = 0; q < 4; ++q) { const unsigned wq = RA[i][q]; const float a_ = __uint_as_float(wq << 16), b_ = __uint_as_float(wq & 0xffff0000u); ss[i] += a_ * a_ + b_ * b_; } } } \
        _Pragma("unroll") for (int i = 0; i < NT; ++i) *(u32x4*)(wB + (ST) * STAGE + (32 * i) * PITCH) = RB[i]; } while (0)
#define GA_COMPUTE(ST) do { _Pragma("unroll") for (int ks = 0; ks < 2; ++ks) { bf16x8 af[MT], bfr[NT]; \
        _Pragma("unroll") for (int mt = 0; mt < MT; ++mt) af[mt] = *(const bf16x8*)(rA + (ST) * STAGE + (mt * 16) * PITCH + (ks ? rc1 : rc0)); \
        _Pragma("unroll") for (int nt = 0; nt < NT; ++nt) bfr[nt] = *(const bf16x8*)(rB + (ST) * STAGE + (nt * 16) * PITCH + (ks ? rc1 : rc0)); \
        _Pragma("unroll") for (int mt = 0; mt < MT; ++mt) _Pragma("unroll") for (int nt = 0; nt < NT; ++nt) \
            acc[mt][nt] = TR ? __builtin_amdgcn_mfma_f32_16x16x32_bf16(bfr[nt], af[mt], acc[mt][nt], 0, 0, 0) \
                             : __builtin_amdgcn_mfma_f32_16x16x32_bf16(af[mt], bfr[nt], acc[mt][nt], 0, 0, 0); } } while (0)
    __syncthreads();
    GA_LOAD(ra0, rb0, 0);
    GA_LOAD(ra1, rb1, 1);
    GA_STORE(ra0, rb0, 0);
    lds_barrier();
    for (int kt = 0; kt < nk; kt += 2) {
        if (kt + 2 < nk) GA_LOAD(ra0, rb0, kt + 2);
        GA_COMPUTE(0);
        GA_STORE(ra1, rb1, 1);
        lds_barrier();
        if (kt + 3 < nk) GA_LOAD(ra1, rb1, kt + 3);
        GA_COMPUTE(1);
        if (kt + 2 < nk) GA_STORE(ra0, rb0, 0);
        lds_barrier();
    }
#undef GA_LOAD
#undef GA_STORE
#undef GA_COMPUTE
    if (ROWSS) {
#pragma unroll
        for (int i = 0; i < MT; ++i) {
            float s_ = ss[i];
            s_ += __shfl_xor(s_, 1); s_ += __shfl_xor(s_, 2); s_ += __shfl_xor(s_, 4);
            if (lch == 0) ss_lds[lrow + 32 * i] = s_;
        }
        __syncthreads();
    }
}

template <int MT, int NT>
DEV void zero_acc(f32x4 (&acc)[MT][NT]) {
#pragma unroll
    for (int a = 0; a < MT; ++a)
#pragma unroll
        for (int b = 0; b < NT; ++b) acc[a][b] = (f32x4){0.f, 0.f, 0.f, 0.f};
}

DEV void tconv(u16* dst, const float* src, int K, int ld, int noff, int nvalid, int ntotal, const float* scale, char* lds) {
    float* tile = (float*)lds;
    const int tid = TID(), tx = tid & 63, ty = tid >> 6;
    const int ntn = ntotal >> 6, ntk = K >> 6;
    for (int t = blockIdx.x; t < ntn * ntk; t += gridDim.x) {
        const int tn = t % ntn, tk = t / ntn, n0 = tn * 64, k0 = tk * 64;
        __syncthreads();
#pragma unroll 4
        for (int r = ty; r < 64; r += 4) {
            const int n = n0 + tx, k = k0 + r;
            float v = 0.f;
            if (n < nvalid) { v = src[(size_t)k * ld + noff + n]; if (scale) v *= scale[k]; }
            tile[r * 65 + tx] = v;
        }
        __syncthreads();
#pragma unroll 4
        for (int r = ty; r < 64; r += 4)
            dst[(size_t)(n0 + r) * K + k0 + tx] = f2bf(tile[tx * 65 + r]);
    }
}

DEV void phase_prologue(const Params& p, char* lds) {
    const size_t gtid = (size_t)blockIdx.x * 256 + TID(), gsz = (size_t)gridDim.x * 256;
    if (gtid < 64) ((int*)(WS(p) + OFF_CTR))[gtid] = 0;
    u16* xb = (u16*)(WS(p) + OFF_XB);
    for (size_t i = gtid; i < (size_t)T_TOK * 256; i += gsz) {
        const size_t e = i * 4;
        const float* src = e < (size_t)T_PROMPT * 1024 ? p.in[0] + e : p.in[1] + (e - (size_t)T_PROMPT * 1024);
        const float4 v = *(const float4*)src;
        uint2 o; o.x = pack2(v.x, v.y); o.y = pack2(v.z, v.w);
        *(uint2*)(xb + e) = o;
    }
    for (int l = 0; l < 2; ++l) {
        u16* W = (u16*)(WS(p) + OFF_W) + (size_t)l * WL_ELEMS;
        tconv(W + W_WIN, p.in[2] + (size_t)l * 1024 * 4640, 1024, 4640, 0, 1568, 1664, nullptr, lds);
        tconv(W + W_WG, p.in[2] + (size_t)l * 1024 * 4640, 1024, 4640, 1568, 3072, 3072, nullptr, lds);
        tconv(W + W_RWP, p.in[14] + (size_t)l * 256 * 1024, 256, 1024, 0, 1024, 1024, nullptr, lds);
        tconv(W + W_MLAP, p.in[19] + (size_t)l * 512 * 1024, 512, 1024, 0, 1024, 1024, nullptr, lds);
        tconv(W + W_S5P, p.in[30] + (size_t)l * 256 * 1024, 256, 1024, 0, 1024, 1024, nullptr, lds);
        tconv(W + W_WOUT, p.in[31] + (size_t)l * 1024 * 1024, 1024, 1024, 0, 1024, 1024, nullptr, lds);
        tconv(W + W_W1, p.in[34] + (size_t)l * 1024 * 4096, 1024, 4096, 0, 4096, 4096, nullptr, lds);
        tconv(W + W_W2, p.in[35] + (size_t)l * 4096 * 1024, 4096, 1024, 0, 1024, 1024, nullptr, lds);
        tconv(W + W_WUQ, p.in[16] + (size_t)l * 256 * 768, 256, 768, 0, 768, 768, p.in[15] + l * 256, lds);
        tconv(W + W_WUKV, p.in[18] + (size_t)l * 128 * 1024, 128, 1024, 0, 1024, 1024, p.in[17] + l * 128, lds);
        tconv(W + W_GLU, p.in[28] + (size_t)l * 256 * 256, 256, 256, 0, 256, 256, nullptr, lds);
    }
    float2* rope = (float2*)(WS(p) + OFF_ROPE);
    for (size_t i = gtid; i < 8192 * 16; i += gsz) {
        const int pos = (int)(i >> 4), j = (int)(i & 15);
        const float inv = __builtin_amdgcn_exp2f(-(float)j * 0.830482023721841f);
        double rev = (double)pos * (double)inv * 0.15915494309189535;
        rev -= floor(rev);
        const float f = (float)rev;
        rope[i] = make_float2(__builtin_amdgcn_cosf(f), __builtin_amdgcn_sinf(f));
    }
    float2* s5a = (float2*)(WS(p) + OFF_S5A);
    float2* s5bb = (float2*)(WS(p) + OFF_S5BB);
    for (size_t i = gtid; i < 4096; i += gsz) {
        const int ldg = (int)(i >> 6);
        const float dt = __expf(p.in[22][ldg]);
        const float lr = p.in[20][i], li = p.in[21][i];
        const float zr = lr * dt, zi = li * dt;
        const float em = expm1f(zr);
        float rv = zi * 0.15915494309189535f; rv -= floorf(rv);
        float rh = 0.5f * zi * 0.15915494309189535f; rh -= floorf(rh);
        const float cz = __builtin_amdgcn_cosf(rv), sz = __builtin_amdgcn_sinf(rv), sh = __builtin_amdgcn_sinf(rh);
        const float are = (em + 1.f) * cz, aim = (em + 1.f) * sz;
        const float nr = em * cz - 2.f * sh * sh, ni = aim;
        const float den = lr * lr + li * li;
        const float cre = (nr * lr + ni * li) / den, cim = (ni * lr - nr * li) / den;
        s5a[i] = make_float2(are, aim);
        for (int c = 0; c < 16; ++c) {
            const float br = p.in[23][i * 16 + c], bi = p.in[24][i * 16 + c];
            s5bb[i * 16 + c] = make_float2(cre * br - cim * bi, cre * bi + cim * br);
        }
    }
}

DEV void phase_zgemm(const Params& p, int l, char* lds) {
    const u16* xb = (const u16*)(WS(p) + OFF_XB);
    const u16* W = (const u16*)(WS(p) + OFF_W) + (size_t)l * WL_ELEMS + W_WIN;
    u16* zrw = (u16*)(WS(p) + OFF_ZRW); u16* zmla = (u16*)(WS(p) + OFF_ZMLA); u16* zs5 = (u16*)(WS(p) + OFF_ZS5);
    const int lane = TID() & 63, wid = TID() >> 6, wr = wid >> 1, wc = wid & 1, fr = lane & 15, g = lane >> 4;
    for (int it = blockIdx.x; it < 640 * 13; it += gridDim.x) {
        const int mi = it / 13, ni = it % 13, m0 = mi * 128, n0 = ni * 128;
        f32x4 acc[4][4]; zero_acc(acc);
        gemm_acc<4, 4, false, true>(acc, xb + (size_t)m0 * 1024, 1024, W + (size_t)n0 * 1024, 1024, 1024, lds, nullptr);
#pragma unroll
        for (int nt = 0; nt < 4; ++nt) {
            const int c0 = n0 + wc * 64 + nt * 16;
            u16* dst; int ld, cc;
            if (c0 < 896) { dst = zrw; ld = 896; cc = c0; }
            else if (c0 < 1312) { dst = zmla; ld = 416; cc = c0 - 896; }
            else if (c0 < 1568) { dst = zs5; ld = 256; cc = c0 - 1312; }
            else continue;
#pragma unroll
            for (int mt = 0; mt < 4; ++mt) {
                const int row = m0 + wr * 64 + mt * 16 + fr;
                u32x2 o; o[0] = pack2(acc[mt][nt][0], acc[mt][nt][1]); o[1] = pack2(acc[mt][nt][2], acc[mt][nt][3]);
                *(u32x2*)(dst + (size_t)row * ld + cc + g * 4) = o;
            }
        }
    }
}

DEV void load_zraw(const u16* zrw, int t0, char* lds) {
    const int pos0 = tok_pos(t0), L = tok_len(t0);
    for (int id = TID(); id < 18 * 112; id += 256) {
        const int r = id / 112, ch = id % 112, pos = pos0 - 1 + r;
        uint4 v = make_uint4(0, 0, 0, 0);
        if (pos >= 0 && pos < L) v = *(const uint4*)(zrw + (size_t)(t0 - 1 + r) * 896 + ch * 8);
        *(uint4*)(lds + r * 1792 + ch * 16) = v;
    }
}
DEV float zshift(const u16* zr, const float* mu, int tl, int col) {
    const float z = bf2f(zr[(tl + 1) * 896 + col]), zm = bf2f(zr[tl * 896 + col]), zp = bf2f(zr[(tl + 2) * 896 + col]);
    return z + mu[col] * (0.5f * (zm + zp) - z);
}

DEV void rwkv_prep_item(const Params& p, int l, int item, char* lds) {
    const int t0 = item * 16, c = TID();
    const u16* zrw = (const u16*)(WS(p) + OFF_ZRW);
    __syncthreads();
    load_zraw(zrw, t0, lds);
    __syncthreads();
    const u16* zr = (const u16*)lds;
    float* act = (float*)(lds + 32768);
    const float* mu = p.in[3] + l * 896;
    for (int id = c; id < 16 * 64; id += 256) {
        const int tl = id >> 6, j = id & 63;
        const float v = zshift(zr, mu, tl, 768 + j);
        act[tl * 64 + j] = j < 32 ? tanhf(v) : v;
    }
    __syncthreads();
    const float* w2 = p.in[5] + (size_t)l * 16384;
    const float* a2 = p.in[7] + (size_t)l * 16384;
    const float w00 = p.in[4][l * 512 + c], w01 = p.in[4][l * 512 + 256 + c];
    const float a00 = p.in[6][l * 512 + c], a01 = p.in[6][l * 512 + 256 + c];
    const float kkc = p.in[9][l * 256 + c];
    __half* comp = (__half*)OUTP(p);
#pragma unroll 1
    for (int th = 0; th < 2; ++th) {
        float wp0[8], wp1[8], ap0[8], ap1[8];
#pragma unroll
        for (int t = 0; t < 8; ++t) { wp0[t] = 0.f; wp1[t] = 0.f; ap0[t] = 0.f; ap1[t] = 0.f; }
        const float* actb = act + th * 8 * 64;
#pragma unroll 2
        for (int k4 = 0; k4 < 8; ++k4) {
            float w20[4], w21[4], a20[4], a21[4];
#pragma unroll
            for (int i = 0; i < 4; ++i) {
                const int k = k4 * 4 + i;
                w20[i] = w2[k * 256 + c]; w21[i] = w2[8192 + k * 256 + c]; a20[i] = a2[k * 256 + c]; a21[i] = a2[8192 + k * 256 + c];
            }
#pragma unroll
            for (int t = 0; t < 8; ++t) {
                const f32x4 xw = *(const f32x4*)(actb + t * 64 + k4 * 4), xa = *(const f32x4*)(actb + t * 64 + 32 + k4 * 4);
#pragma unroll
                for (int i = 0; i < 4; ++i) { wp0[t] += xw[i] * w20[i]; wp1[t] += xw[i] * w21[i]; ap0[t] += xa[i] * a20[i]; ap1[t] += xa[i] * a21[i]; }
            }
        }
        const float mur = mu[c], muk = mu[256 + c], muv = mu[512 + c];
        float zmr = bf2f(zr[(th * 8) * 896 + c]), zcr = bf2f(zr[(th * 8 + 1) * 896 + c]);
        float zmk = bf2f(zr[(th * 8) * 896 + 256 + c]), zck = bf2f(zr[(th * 8 + 1) * 896 + 256 + c]);
        float zmv = bf2f(zr[(th * 8) * 896 + 512 + c]), zcv = bf2f(zr[(th * 8 + 1) * 896 + 512 + c]);
#pragma unroll
        for (int t = 0; t < 8; ++t) {
            const int tl = th * 8 + t;
            const float zpr = bf2f(zr[(tl + 2) * 896 + c]), zpk = bf2f(zr[(tl + 2) * 896 + 256 + c]), zpv = bf2f(zr[(tl + 2) * 896 + 512 + c]);
            const float r = zcr + mur * (0.5f * (zmr + zpr) - zcr), k = zck + muk * (0.5f * (zmk + zpk) - zck), v = zcv + muv * (0.5f * (zmv + zpv) - zcv);
            zmr = zcr; zcr = zpr; zmk = zck; zck = zpk; zmv = zcv; zcv = zpv;
            const float kr = k * kkc;
            const float ssum = wave_sum(kr * kr);
            const float kkn = kr * rsqrtf(fmaxf(ssum, 1e-12f));
            const float ew0 = 0.60653066f * sigm(w00 + wp0[t]), ew1 = 0.60653066f * sigm(w01 + wp1[t]);
            const float av0 = sigm(a00 + ap0[t]), av1 = sigm(a01 + ap1[t]);
            __half* row = comp + (size_t)(t0 + tl) * 2048;
            row[c] = __float2half(kkn); row[256 + c] = __float2half(r); row[512 + c] = __float2half(k); row[768 + c] = __float2half(v);
            row[1024 + c] = __float2half(ew0); row[1280 + c] = __float2half(ew1); row[1536 + c] = __float2half(av0); row[1792 + c] = __float2half(av1);
        }
    }
}

DEV void unpack16(const uint4 a, const uint4 b, float (&u)[16]) {
    const unsigned w[8] = {a.x, a.y, a.z, a.w, b.x, b.y, b.z, b.w};
#pragma unroll
    for (int i = 0; i < 8; ++i) { u[2 * i] = __uint_as_float(w[i] << 16); u[2 * i + 1] = __uint_as_float(w[i] & 0xffff0000u); }
}

DEV void s5_passA(const Params& p, int l, int item) {
    const int lane = TID() & 63, w = TID() >> 6;
    const int ci = item >> 2, g = (item & 3) * 4 + w, t0 = ci * 256;
    const u16* zs5 = (const u16*)(WS(p) + OFF_ZS5);
    const float2* s5a = (const float2*)(WS(p) + OFF_S5A);
    const float2* s5bb = (const float2*)(WS(p) + OFF_S5BB);
    float2* E = (float2*)(WS(p) + OFF_S5E);
    for (int d = 0; d < 2; ++d) {
        const int pi = ((l * 2 + d) * 16 + g) * 64 + lane;
        const float2 a = s5a[pi];
        float2 bb[16];
#pragma unroll
        for (int c = 0; c < 16; ++c) bb[c] = s5bb[(size_t)pi * 16 + c];
        float xr = 0.f, xi = 0.f;
        for (int n = 0; n < 256; ++n) {
            const int t = d ? t0 + 255 - n : t0 + n;
            const uint4* up = (const uint4*)(zs5 + (size_t)t * 256 + g * 16);
            float u[16]; unpack16(up[0], up[1], u);
            float br = 0.f, bi = 0.f;
#pragma unroll
            for (int c = 0; c < 16; ++c) { br += u[c] * bb[c].x; bi += u[c] * bb[c].y; }
            const float nr = a.x * xr - a.y * xi + br, ni = a.x * xi + a.y * xr + bi;
            xr = nr; xi = ni;
        }
        E[(size_t)((ci * 16 + g) * 2 + d) * 64 + lane] = make_float2(xr, xi);
    }
}

DEV float gelu_tanh(float y) { return 0.5f * y * (1.f + tanhf(0.7978845608f * (y + 0.044715f * y * y * y))); }

DEV void s5_passC(const Params& p, int l, int item, char* lds) {
    const int lane = TID() & 63, w = TID() >> 6, fr = lane & 15, gq = lane >> 4;
    const int ci = item >> 2, g = (item & 3) * 4 + w, t0 = ci * 256;
    const int pos0 = tok_pos(t0), L = tok_len(t0), s0 = t0 - pos0;
    const int kc = pos0 >> 8, nck = L >> 8, ci0 = s0 >> 8;
    const u16* zs5 = (const u16*)(WS(p) + OFF_ZS5);
    u16* yg = (u16*)(WS(p) + OFF_YG);
    const float2* s5a = (const float2*)(WS(p) + OFF_S5A);
    const float2* s5bb = (const float2*)(WS(p) + OFF_S5BB);
    const float2* E = (const float2*)(WS(p) + OFF_S5E);
    u16* Xs = (u16*)(lds + w * 4352);
    const float dsk = p.in[27][l * 256 + g * 16 + fr];
    __syncthreads();
    for (int d = 0; d < 2; ++d) {
        const int pi = ((l * 2 + d) * 16 + g) * 64 + lane;
        const float2 a = s5a[pi];
        float2 bb[16];
#pragma unroll
        for (int c = 0; c < 16; ++c) bb[c] = s5bb[(size_t)pi * 16 + c];
        float2 aP = a;
#pragma unroll
        for (int i = 0; i < 8; ++i) aP = make_float2(aP.x * aP.x - aP.y * aP.y, 2.f * aP.x * aP.y);
        float xr = 0.f, xi = 0.f;
        if (d == 0) {
            for (int k2 = 0; k2 < kc; ++k2) {
                const float2 e = E[(size_t)(((ci0 + k2) * 16 + g) * 2 + 0) * 64 + lane];
                const float nr = aP.x * xr - aP.y * xi + e.x, ni = aP.x * xi + aP.y * xr + e.y; xr = nr; xi = ni;
            }
        } else {
            for (int k2 = nck - 1; k2 > kc; --k2) {
                const float2 e = E[(size_t)(((ci0 + k2) * 16 + g) * 2 + 1) * 64 + lane];
                const float nr = aP.x * xr - aP.y * xi + e.x, ni = aP.x * xi + aP.y * xr + e.y; xr = nr; xi = ni;
            }
        }
        bf16x8 cf[4];
        const float* cre = p.in[25] + (size_t)(((l * 2 + d) * 16 + g) * 16 + fr) * 64;
        const float* cim = p.in[26] + (size_t)(((l * 2 + d) * 16 + g) * 16 + fr) * 64;
#pragma unroll
        for (int ks = 0; ks < 4; ++ks)
#pragma unroll
            for (int e = 0; e < 8; ++e) {
                const int k = ks * 32 + gq * 8 + e, pp = k >> 1;
                const float v = (k & 1) ? -cim[pp] : cre[pp];
                cf[ks][e] = (short)f2bf(v);
            }
        for (int sc = 0; sc < 16; ++sc) {
            const int tb = d ? t0 + 240 - sc * 16 : t0 + sc * 16;
            for (int s = 0; s < 16; ++s) {
                const int tl = d ? 15 - s : s, t = tb + tl;
                const uint4* up = (const uint4*)(zs5 + (size_t)t * 256 + g * 16);
                float u[16]; unpack16(up[0], up[1], u);
                float br = 0.f, bi = 0.f;
#pragma unroll
                for (int c = 0; c < 16; ++c) { br += u[c] * bb[c].x; bi += u[c] * bb[c].y; }
                const float nr = a.x * xr - a.y * xi + br, ni = a.x * xi + a.y * xr + bi;
                xr = nr; xi = ni;
                *(unsigned*)(Xs + tl * 136 + lane * 2) = pack2(xr, xi);
            }
            __builtin_amdgcn_fence(__ATOMIC_RELEASE, "wavefront");
            __builtin_amdgcn_wave_barrier();
            asm volatile("s_waitcnt lgkmcnt(0)" ::: "memory");
            f32x4 y = (f32x4){0.f, 0.f, 0.f, 0.f};
#pragma unroll
            for (int ks = 0; ks < 4; ++ks) {
                const bf16x8 xa = *(const bf16x8*)(Xs + fr * 136 + ks * 32 + gq * 8);
                y = __builtin_amdgcn_mfma_f32_16x16x32_bf16(xa, cf[ks], y, 0, 0, 0);
            }
            asm volatile("s_waitcnt lgkmcnt(0)" ::: "memory");
            __builtin_amdgcn_wave_barrier();
#pragma unroll
            for (int e = 0; e < 4; ++e) {
                const int t = tb + gq * 4 + e;
                const size_t idx = (size_t)t * 256 + g * 16 + fr;
                if (d == 0) yg[idx] = f2bf(y[e]);
                else {
                    const float uu = bf2f(zs5[idx]);
                    const float yy = bf2f(yg[idx]) + y[e] + dsk * uu;
                    yg[idx] = f2bf(gelu_tanh(yy));
                }
            }
        }
    }
}

DEV void krope_item(const Params& p, int item) {
    const u16* zmla = (const u16*)(WS(p) + OFF_ZMLA);
    u16* kr = (u16*)(WS(p) + OFF_KR);
    const float2* rope = (const float2*)(WS(p) + OFF_ROPE);
    const int t0 = item * 256;
    for (int id = TID(); id < 4096; id += 256) {
        const int t = t0 + (id >> 4), j = id & 15, pos = tok_pos(t);
        const float z1 = bf2f(zmla[(size_t)t * 416 + 384 + j]), z2 = bf2f(zmla[(size_t)t * 416 + 400 + j]);
        const float2 cs = rope[pos * 16 + j];
        kr[(size_t)t * 32 + j] = f2bf(z1 * cs.x - z2 * cs.y);
        kr[(size_t)t * 32 + 16 + j] = f2bf(z1 * cs.y + z2 * cs.x);
    }
}

DEV void mla_q_tile(const Params& p, int l, int it, char* lds) {
    const int mi = it / 6, ni = it % 6, m0 = mi * 128, n0 = ni * 128;
    const u16* zmla = (const u16*)(WS(p) + OFF_ZMLA);
    const u16* W = (const u16*)(WS(p) + OFF_W) + (size_t)l * WL_ELEMS + W_WUQ;
    u16* q = (u16*)(WS(p) + OFF_Q);
    const float2* rope = (const float2*)(WS(p) + OFF_ROPE);
    float* ssl = (float*)(lds + 73728);
    const int lane = TID() & 63, wid = TID() >> 6, wr = wid >> 1, wc = wid & 1, fr = lane & 15, g = lane >> 4;
    f32x4 acc[4][4]; zero_acc(acc);
    gemm_acc<4, 4, true, true>(acc, zmla + (size_t)m0 * 416, 416, W + (size_t)n0 * 256, 256, 256, lds, ssl);
    const float QS = 0.10206207261596577f * 1.4426950408889634f;
#pragma unroll
    for (int mt = 0; mt < 4; ++mt) {
        const int rl = wr * 64 + mt * 16 + fr, row = m0 + rl;
        const float rs = rsqrtf(ssl[rl] * (1.f / 256.f) + 1e-6f) * QS;
        const float2* cp = rope + tok_pos(row) * 16 + g * 4;
        u16* qrow = q + (size_t)row * 768 + n0 + wc * 64 + g * 4;
#pragma unroll
        for (int nt = 0; nt < 4; nt += 2) {
            const int c0 = n0 + wc * 64 + nt * 16;
            f32x4 v0 = acc[mt][nt] * rs, v1 = acc[mt][nt + 1] * rs;
            if ((c0 % 96) == 64) {
#pragma unroll
                for (int e = 0; e < 4; ++e) {
                    const float2 cs = cp[e];
                    const float t1 = v0[e], t2 = v1[e];
                    v0[e] = t1 * cs.x - t2 * cs.y; v1[e] = t1 * cs.y + t2 * cs.x;
                }
            }
            u32x2 o0, o1; o0[0] = pack2(v0[0], v0[1]); o0[1] = pack2(v0[2], v0[3]); o1[0] = pack2(v1[0], v1[1]); o1[1] = pack2(v1[2], v1[3]);
            *(u32x2*)(qrow + nt * 16) = o0;
            *(u32x2*)(qrow + nt * 16 + 16) = o1;
        }
        asm volatile("" ::: "memory");
    }
}

DEV void mla_kv_tile(const Params& p, int l, int it, char* lds) {
    const int mi = it >> 3, h = it & 7, m0 = mi * 128;
    const u16* zmla = (const u16*)(WS(p) + OFF_ZMLA);
    const u16* W = (const u16*)(WS(p) + OFF_W) + (size_t)l * WL_ELEMS + W_WUKV;
    u16* kb = (u16*)(WS(p) + OFF_K);
    u16* vT = (u16*)(WS(p) + OFF_VT);
    float* ssl = (float*)(lds + 73728);
    const int lane = TID() & 63, wid = TID() >> 6, wr = wid >> 1, wc = wid & 1, fr = lane & 15, g = lane >> 4;
    f32x4 acc[4][4]; zero_acc(acc);
    gemm_acc<4, 4, true, false>(acc, zmla + (size_t)m0 * 416 + 256, 416, W + (size_t)(h * 128) * 128, 128, 128, lds, ssl);
    const int pos0 = tok_pos(m0), L = tok_len(m0), s0 = m0 - pos0;
#pragma unroll
    for (int mt = 0; mt < 4; ++mt) {
        const int rl0 = wr * 64 + mt * 16 + g * 4;
        float rs[4];
#pragma unroll
        for (int e = 0; e < 4; ++e) rs[e] = rsqrtf(ssl[rl0 + e] * (1.f / 128.f) + 1e-6f);
#pragma unroll
        for (int nt = 0; nt < 4; ++nt) {
            const int cw = nt * 16 + fr;
            if (wc == 0) {
#pragma unroll
                for (int e = 0; e < 4; ++e) kb[(size_t)(m0 + rl0 + e) * 512 + h * 64 + cw] = f2bf(acc[mt][nt][e] * rs[e]);
            } else {
                uint2 o; o.x = pack2(acc[mt][nt][0] * rs[0], acc[mt][nt][1] * rs[1]); o.y = pack2(acc[mt][nt][2] * rs[2], acc[mt][nt][3] * rs[3]);
                *(uint2*)(vT + (size_t)s0 * 512 + (size_t)(h * 64 + cw) * L + pos0 + rl0) = o;
            }
        }
    }
}

DEV float bcast_row0(float x) {
    auto r = __builtin_amdgcn_permlane16_swap(__float_as_uint(x), __float_as_uint(x), false, false);
    auto q = __builtin_amdgcn_permlane32_swap(r[0], r[0], false, false);
    return __uint_as_float(q[0]);
}
DEV void rwkv_scan_unit(const Params& p, int l, int unit, char* lds, int rep = 0) {
    int seq, h, dir;
    if (unit < 64) { seq = unit >> 3; h = (unit >> 1) & 3; dir = unit & 1; }
    else { const int u = unit - 64; seq = 8 + (u >> 3); h = (u >> 1) & 3; dir = u & 1; }
    const int L = seq < 8 ? 8192 : 4096, s0 = seq < 8 ? seq * 8192 : T_PROMPT + (seq - 8) * 4096;
    const int tid = TID(), lane = tid & 63, w = tid >> 6, il = lane & 15, g = lane >> 4;
    float* opf = (float*)lds;
    u16* opa = (u16*)(opf + 32 * 2 * 64);
    float* vs = (float*)(opa + 32 * 4 * 64);
    float* cc = vs + 32 * 64;
    float* gc = cc + 64;
    float* tot = gc + 64;
    float* obuf = tot + 256;
    f32x2 S2[8];
#pragma unroll
    for (int j = 0; j < 8; ++j) S2[j] = (f32x2){0.f, 0.f};
    const __half* comp = (const __half*)OUTP(p);
    const float ka = p.in[10][l * 256 + h * 64 + lane];
    u16* ob = (u16*)(WS(p) + OFF_OFB) + (size_t)dir * T_TOK * 256;
    const int nch = L / 32;
    __half hkk[8], hr[8], hk[8], hv[8], hew[8], ha[8];
#pragma unroll
    for (int s = 0; s < 8; ++s) {
        const int n = w * 8 + s, pos = dir ? L - 1 - n : n;
        const __half* row = comp + (size_t)(s0 + pos) * 2048 + h * 64 + lane;
        hkk[s] = row[0]; hr[s] = row[256]; hk[s] = row[512]; hv[s] = row[768]; hew[s] = row[1024 + dir * 256]; ha[s] = row[1536 + dir * 256];
    }
    lds_barrier();
    for (int ch = 0; ch < nch; ++ch) {
        float ew[8], cum[8], kkv[8], rv[8], kv[8], av[8];
        float run = 0.f;
#pragma unroll
        for (int s = 0; s < 8; ++s) {
            kkv[s] = __half2float(hkk[s]); rv[s] = __half2float(hr[s]); kv[s] = __half2float(hk[s]);
            ew[s] = __half2float(hew[s]); av[s] = __half2float(ha[s]);
            vs[(w * 8 + s) * 64 + lane] = __half2float(hv[s]);
            run += ew[s]; cum[s] = run;
        }
        tot[w * 64 + lane] = run;
        if (ch + 1 < nch) {
#pragma unroll
            for (int s = 0; s < 8; ++s) {
                const int n = (ch + 1) * 32 + w * 8 + s, pos = dir ? L - 1 - n : n;
                const __half* row = comp + (size_t)(s0 + pos) * 2048 + h * 64 + lane;
                hkk[s] = row[0]; hr[s] = row[256]; hk[s] = row[512]; hv[s] = row[768]; hew[s] = row[1024 + dir * 256]; ha[s] = row[1536 + dir * 256];
            }
        }
        lds_barrier();
        float off = 0.f;
#pragma unroll
        for (int w2 = 0; w2 < 3; ++w2) if (w2 < w) off += tot[w2 * 64 + lane];
        if (w == 0) gc[lane] = __expf(-(tot[lane] + tot[64 + lane] + tot[128 + lane] + tot[192 + lane]));
#pragma unroll
        for (int s = 0; s < 8; ++s) {
            const float ct = off + cum[s], cp = ct - ew[s];
            const float Gt = __expf(-ct), Gp = __expf(-cp), iG = __expf(ct);
            const float b = kkv[s] * av[s], kd = kv[s] * (1.f + (av[s] - 1.f) * ka);
            const int sl = w * 8 + s;
            const float kt = kkv[s] * Gp, rt = rv[s] * Gt;
            const u16 kth = f2bf(kt), rth = f2bf(rt);
            opa[(sl * 4 + 0) * 64 + lane] = kth;
            opa[(sl * 4 + 1) * 64 + lane] = rth;
            opa[(sl * 4 + 2) * 64 + lane] = f2bf(kt - bf2f(kth));
            opa[(sl * 4 + 3) * 64 + lane] = f2bf(rt - bf2f(rth));
            opf[(sl * 2 + 0) * 64 + lane] = b * iG;
            opf[(sl * 2 + 1) * 64 + lane] = kd * iG;
            const float c1 = wave_sum(b * rv[s]), c2 = wave_sum(kd * rv[s]);
            if (lane == 0) { cc[sl * 2] = c1; cc[sl * 2 + 1] = c2; }
        }
        lds_barrier();
        const int aoff = (lane & 3) * 64 + g * 8;
        bf16x8 a0 = *(const bf16x8*)(opa + aoff), a1 = *(const bf16x8*)(opa + aoff + 32);
        for (int sl = 0; sl < ((SCANVAR == 3 && rep) ? 0 : 32); ++sl) {
            union { bf16x8 v; unsigned u[4]; } b0, b1;
#pragma unroll
            for (int q = 0; q < 4; ++q) { b0.u[q] = pack2(S2[q].x, S2[q].y); b1.u[q] = pack2(S2[4 + q].x, S2[4 + q].y); }
            f32x4 D = (f32x4){0.f, 0.f, 0.f, 0.f};
            D = __builtin_amdgcn_mfma_f32_16x16x32_bf16(a0, b0.v, D, 0, 0, 0);
            D = __builtin_amdgcn_mfma_f32_16x16x32_bf16(a1, b1.v, D, 0, 0, 0);
            const f32x4* f4 = (const f32x4*)(opf + sl * 128);
            f32x4 BH[4], KH[4];
            if (SCANVAR == 2 && rep) { const f32x4 cst = (f32x4){1e-3f, 2e-3f, 1e-3f, 3e-3f};
                BH[0] = cst; BH[1] = cst; BH[2] = cst; BH[3] = cst; KH[0] = cst; KH[1] = cst; KH[2] = cst; KH[3] = cst; }
            else {
            BH[0] = f4[g * 2]; BH[1] = f4[g * 2 + 1]; BH[2] = f4[8 + g * 2]; BH[3] = f4[8 + g * 2 + 1];
            KH[0] = f4[16 + g * 2]; KH[1] = f4[16 + g * 2 + 1]; KH[2] = f4[24 + g * 2]; KH[3] = f4[24 + g * 2 + 1]; }
            const float v = vs[sl * 64 + w * 16 + il];
            const float c1 = cc[sl * 2], c2 = cc[sl * 2 + 1];
            {
                const u16* na = opa + (sl < 31 ? sl + 1 : 31) * 256 + aoff;
                a0 = *(const bf16x8*)na; a1 = *(const bf16x8*)(na + 32);
            }
            const float u = D[0] + D[2], o1 = D[1] + D[3];
            obuf[sl * 64 + w * 16 + il] = o1 - u * c1 + v * c2;
            const f32x2 vv2 = (f32x2){v, v}, nu2 = (f32x2){-u, -u};
#pragma unroll
            for (int q = 0; q < 4; ++q) {
                S2[2 * q] = __builtin_elementwise_fma(vv2, (f32x2){KH[q][0], KH[q][1]}, __builtin_elementwise_fma(nu2, (f32x2){BH[q][0], BH[q][1]}, S2[2 * q]));
                S2[2 * q + 1] = __builtin_elementwise_fma(vv2, (f32x2){KH[q][2], KH[q][3]}, __builtin_elementwise_fma(nu2, (f32x2){BH[q][2], BH[q][3]}, S2[2 * q + 1]));
            }
        }
#pragma unroll
        for (int q = 0; q < 4; ++q) {
            S2[q] *= *(const f32x2*)(gc + g * 8 + 2 * q);
            S2[4 + q] *= *(const f32x2*)(gc + 32 + g * 8 + 2 * q);
        }
        lds_barrier();
        if (!rep)
#pragma unroll
        for (int i = 0; i < 8; ++i) {
            const int idx = tid + i * 256, sl = idx >> 6, c = idx & 63;
            const int n = ch * 32 + sl, pos = dir ? L - 1 - n : n;
            ob[(size_t)(s0 + pos) * 256 + h * 64 + c] = f2bf(obuf[idx]);
        }
    }
    lds_barrier();
}

DEV void attn_item(const Params& p, int item, char* lds) {
    int seq, h, qt;
    if (item < 4096) { seq = item >> 9; const int r = item & 511; h = r >> 6; qt = r & 63; }
    else { int r = item - 4096; seq = 8 + (r >> 8); r &= 255; h = r >> 5; qt = r & 31; }
    const int L = seq < 8 ? 8192 : 4096, s0 = seq < 8 ? seq * 8192 : T_PROMPT + (seq - 8) * 4096;
    const int tid = TID(), lane = tid & 63, wid = tid >> 6, fr = lane & 15, g = lane >> 4;
    const int q0 = s0 + qt * 128 + wid * 32;
    const u16* qb = (const u16*)(WS(p) + OFF_Q);
    const u16* kb = (const u16*)(WS(p) + OFF_K) + (size_t)s0 * 512 + h * 64;
    const u16* krb = (const u16*)(WS(p) + OFF_KR) + (size_t)s0 * 32;
    const u16* vb = (const u16*)(WS(p) + OFF_VT) + (size_t)s0 * 512 + (size_t)h * 64 * L;
    u16* oc = (u16*)(WS(p) + OFF_OCAT);
    constexpr int KP = 208, VP = 144, VOFF = 64 * KP, ASTAGE = VOFF + 64 * VP;
    bf16x8 qf[2][3];
#pragma unroll
    for (int nt = 0; nt < 2; ++nt)
#pragma unroll
        for (int ks = 0; ks < 3; ++ks) qf[nt][ks] = *(const bf16x8*)(qb + (size_t)(q0 + nt * 16 + fr) * 768 + h * 96 + ks * 32 + g * 8);
    f32x4 oT[4][2];
#pragma unroll
    for (int a = 0; a < 4; ++a) { oT[a][0] = (f32x4){0.f, 0.f, 0.f, 0.f}; oT[a][1] = (f32x4){0.f, 0.f, 0.f, 0.f}; }
    float mrow[2] = {-1e30f, -1e30f}, lsum[2] = {0.f, 0.f};
    const int krow = tid >> 3, kch = tid & 7, rrow = tid >> 2, rch = tid & 3;
    u32x4 rk0, rk1, rkr, rv0, rv1;
    const int ntile = L / 64;
    __syncthreads();
    {
        rk0 = *(const u32x4*)(kb + (size_t)krow * 512 + kch * 8);
        rk1 = *(const u32x4*)(kb + (size_t)(krow + 32) * 512 + kch * 8);
        rkr = *(const u32x4*)(krb + (size_t)rrow * 32 + rch * 8);
        rv0 = *(const u32x4*)(vb + (size_t)krow * L + kch * 8);
        rv1 = *(const u32x4*)(vb + (size_t)(krow + 32) * L + kch * 8);
    }
    for (int kt = 0; kt < ntile; ++kt) {
        char* st = lds + (kt & 1) * ASTAGE;
        *(u32x4*)(st + krow * KP + kch * 16) = rk0;
        *(u32x4*)(st + (krow + 32) * KP + kch * 16) = rk1;
        *(u32x4*)(st + rrow * KP + 128 + rch * 16) = rkr;
        *(u32x4*)(st + VOFF + krow * VP + kch * 16) = rv0;
        *(u32x4*)(st + VOFF + (krow + 32) * VP + kch * 16) = rv1;
        __syncthreads();
        if (kt + 1 < ntile) {
            const int key0 = (kt + 1) * 64;
            rk0 = *(const u32x4*)(kb + (size_t)(key0 + krow) * 512 + kch * 8);
            rk1 = *(const u32x4*)(kb + (size_t)(key0 + krow + 32) * 512 + kch * 8);
            rkr = *(const u32x4*)(krb + (size_t)(key0 + rrow) * 32 + rch * 8);
            rv0 = *(const u32x4*)(vb + (size_t)krow * L + key0 + kch * 8);
            rv1 = *(const u32x4*)(vb + (size_t)(krow + 32) * L + key0 + kch * 8);
        }
        f32x4 sc[4][2];
#pragma unroll
        for (int a = 0; a < 4; ++a) { sc[a][0] = (f32x4){0.f, 0.f, 0.f, 0.f}; sc[a][1] = (f32x4){0.f, 0.f, 0.f, 0.f}; }
#pragma unroll
        for (int ks = 0; ks < 3; ++ks) {
            bf16x8 kf[4];
#pragma unroll
            for (int mt = 0; mt < 4; ++mt) kf[mt] = *(const bf16x8*)(st + (mt * 16 + fr) * KP + (ks * 4 + g) * 16);
#pragma unroll
            for (int mt = 0; mt < 4; ++mt)
#pragma unroll
                for (int nt = 0; nt < 2; ++nt) sc[mt][nt] = __builtin_amdgcn_mfma_f32_16x16x32_bf16(kf[mt], qf[nt][ks], sc[mt][nt], 0, 0, 0);
        }
        bf16x8 pb[2][2];
#pragma unroll
        for (int nt = 0; nt < 2; ++nt) {
            float mx = -1e30f;
#pragma unroll
            for (int mt = 0; mt < 4; ++mt)
#pragma unroll
                for (int e = 0; e < 4; ++e) mx = fmaxf(mx, sc[mt][nt][e]);
            mx = fmaxf(mx, __shfl_xor(mx, 16)); mx = fmaxf(mx, __shfl_xor(mx, 32));
            const float mn = fmaxf(mrow[nt], mx);
            const float al = __builtin_amdgcn_exp2f(mrow[nt] - mn);
            mrow[nt] = mn;
            float rs = 0.f;
#pragma unroll
            for (int mt = 0; mt < 4; ++mt)
#pragma unroll
                for (int e = 0; e < 4; ++e) { const float pv = __builtin_amdgcn_exp2f(sc[mt][nt][e] - mn); sc[mt][nt][e] = pv; rs += pv; }
            lsum[nt] = lsum[nt] * al + rs;
#pragma unroll
            for (int a = 0; a < 4; ++a) oT[a][nt] *= al;
#pragma unroll
            for (int s = 0; s < 2; ++s) {
                union { bf16x8 v; unsigned u[4]; } pk;
                pk.u[0] = pack2(sc[2 * s][nt][0], sc[2 * s][nt][1]); pk.u[1] = pack2(sc[2 * s][nt][2], sc[2 * s][nt][3]);
                pk.u[2] = pack2(sc[2 * s + 1][nt][0], sc[2 * s + 1][nt][1]); pk.u[3] = pack2(sc[2 * s + 1][nt][2], sc[2 * s + 1][nt][3]);
                pb[nt][s] = pk.v;
            }
        }
#pragma unroll
        for (int s = 0; s < 2; ++s)
#pragma unroll
            for (int dvt = 0; dvt < 4; ++dvt) {
                const char* vp = st + VOFF + (dvt * 16 + fr) * VP + (32 * s + 4 * g) * 2;
                union { bf16x8 v; u32x2 u[2]; } vf;
                vf.u[0] = *(const u32x2*)vp; vf.u[1] = *(const u32x2*)(vp + 32);
#pragma unroll
                for (int nt = 0; nt < 2; ++nt) oT[dvt][nt] = __builtin_amdgcn_mfma_f32_16x16x32_bf16(vf.v, pb[nt][s], oT[dvt][nt], 0, 0, 0);
            }
    }
#pragma unroll
    for (int nt = 0; nt < 2; ++nt) {
        float lt = lsum[nt];
        lt += __shfl_xor(lt, 16); lt += __shfl_xor(lt, 32);
        const float inv = 1.f / lt;
        const int tok = q0 + nt * 16 + fr;
#pragma unroll
        for (int dvt = 0; dvt < 4; ++dvt) {
            uint2 o; o.x = pack2(oT[dvt][nt][0] * inv, oT[dvt][nt][1] * inv); o.y = pack2(oT[dvt][nt][2] * inv, oT[dvt][nt][3] * inv);
            *(uint2*)(oc + (size_t)tok * 1024 + 256 + h * 64 + dvt * 16 + g * 4) = o;
        }
    }
}

DEV void rwkv_post_item(const Params& p, int l, int item, char* lds) {
    const int t0 = item * 16, c = TID();
    const u16* zrw = (const u16*)(WS(p) + OFF_ZRW);
    __syncthreads();
    load_zraw(zrw, t0, lds);
    __syncthreads();
    const u16* zr = (const u16*)lds;
    float* act = (float*)(lds + 32768);
    const float* mu = p.in[3] + l * 896;
    for (int id = c; id < 16 * 64; id += 256) {
        const int tl = id >> 6, j = id & 63;
        act[tl * 64 + j] = sigm(zshift(zr, mu, tl, 832 + j));
    }
    __syncthreads();
    const float* g2 = p.in[8] + (size_t)l * 16384;
    const float gng = p.in[12][l * 256 + c], gnb = p.in[13][l * 256 + c], rk = p.in[11][l * 256 + c];
    const u16* of = (const u16*)(WS(p) + OFF_OFB);
    const u16* obk = of + (size_t)T_TOK * 256;
    u16* oc = (u16*)(WS(p) + OFF_OCAT);
#pragma unroll 1
    for (int th = 0; th < 2; ++th) {
        float ga[8];
#pragma unroll
        for (int t = 0; t < 8; ++t) ga[t] = 0.f;
        const float* actb = act + th * 8 * 64;
#pragma unroll 4
        for (int k4 = 0; k4 < 16; ++k4) {
            float gw[4];
#pragma unroll
            for (int i = 0; i < 4; ++i) gw[i] = g2[(k4 * 4 + i) * 256 + c];
#pragma unroll
            for (int t = 0; t < 8; ++t) {
                const f32x4 xg = *(const f32x4*)(actb + t * 64 + k4 * 4);
#pragma unroll
                for (int i = 0; i < 4; ++i) ga[t] += xg[i] * gw[i];
            }
        }
        const float mur = mu[c], muk = mu[256 + c], muv = mu[512 + c];
        float zmr = bf2f(zr[(th * 8) * 896 + c]), zcr = bf2f(zr[(th * 8 + 1) * 896 + c]);
        float zmk = bf2f(zr[(th * 8) * 896 + 256 + c]), zck = bf2f(zr[(th * 8 + 1) * 896 + 256 + c]);
        float zmv = bf2f(zr[(th * 8) * 896 + 512 + c]), zcv = bf2f(zr[(th * 8 + 1) * 896 + 512 + c]);
#pragma unroll
        for (int t = 0; t < 8; ++t) {
            const int tl = th * 8 + t;
            const float zpr = bf2f(zr[(tl + 2) * 896 + c]), zpk = bf2f(zr[(tl + 2) * 896 + 256 + c]), zpv = bf2f(zr[(tl + 2) * 896 + 512 + c]);
            const float r = zcr + mur * (0.5f * (zmr + zpr) - zcr), k = zck + muk * (0.5f * (zmk + zpk) - zck), v = zcv + muv * (0.5f * (zmv + zpv) - zcv);
            zmr = zcr; zcr = zpr; zmk = zck; zck = zpk; zmv = zcv; zcv = zpv;
            const float o = bf2f(of[(size_t)(t0 + tl) * 256 + c]) + bf2f(obk[(size_t)(t0 + tl) * 256 + c]);
            const float mean = wave_sum(o) * (1.f / 64.f), dlt = o - mean;
            const float var = wave_sum(dlt * dlt) * (1.f / 64.f);
            const float on = dlt * rsqrtf(var + 64e-5f) * gng + gnb;
            const float bonus = wave_sum(r * k * rk) * v;
            oc[(size_t)(t0 + tl) * 1024 + c] = f2bf((on + bonus) * ga[t]);
        }
    }
}

DEV void s5_glu_tile(const Params& p, int l, int it, char* lds) {
    const int mi = it >> 1, ni = it & 1, m0 = mi * 128, n0 = ni * 128;
    const u16* yg = (const u16*)(WS(p) + OFF_YG);
    const u16* W = (const u16*)(WS(p) + OFF_W) + (size_t)l * WL_ELEMS + W_GLU;
    u16* oc = (u16*)(WS(p) + OFF_OCAT);
    const float* gb = p.in[29] + l * 256;
    const int lane = TID() & 63, wid = TID() >> 6, wr = wid >> 1, wc = wid & 1, fr = lane & 15, g = lane >> 4;
    f32x4 acc[4][4]; zero_acc(acc);
    gemm_acc<4, 4, false, true>(acc, yg + (size_t)m0 * 256, 256, W + (size_t)n0 * 256, 256, 256, lds, nullptr);
#pragma unroll
    for (int nt = 0; nt < 4; ++nt) {
        const int col = n0 + wc * 64 + nt * 16 + g * 4;
        const f32x4 bias = *(const f32x4*)(gb + col);
#pragma unroll
        for (int mt = 0; mt < 4; ++mt) {
            const int row = m0 + wr * 64 + mt * 16 + fr;
            const u32x2 yv = *(const u32x2*)(yg + (size_t)row * 256 + col);
            const float y0 = __uint_as_float(yv[0] << 16), y1 = __uint_as_float(yv[0] & 0xffff0000u), y2 = __uint_as_float(yv[1] << 16), y3 = __uint_as_float(yv[1] & 0xffff0000u);
            u32x2 o; o[0] = pack2(y0 * sigm(acc[mt][nt][0] + bias[0]), y1 * sigm(acc[mt][nt][1] + bias[1]));
            o[1] = pack2(y2 * sigm(acc[mt][nt][2] + bias[2]), y3 * sigm(acc[mt][nt][3] + bias[3]));
            *(u32x2*)(oc + (size_t)row * 1024 + 768 + col) = o;
        }
    }
}

DEV void merge_branch(u32x2 (&mgp)[4][2], const u16* xbt, const u16* Wg, const u16* ocb, const u16* Pt, int Kb, char* lds) {
    u32x2 gp[4][2];
    {
        f32x4 ag[4][2];
        zero_acc(ag);
        gemm_acc<4, 2, false, true>(ag, xbt, 1024, Wg, 1024, 1024, lds, nullptr);
#pragma unroll
        for (int a = 0; a < 4; ++a)
#pragma unroll
            for (int b = 0; b < 2; ++b) {
                gp[a][b][0] = pack2(sigm(ag[a][b][0]), sigm(ag[a][b][1]));
                gp[a][b][1] = pack2(sigm(ag[a][b][2]), sigm(ag[a][b][3]));
            }
    }
    asm volatile("" ::: "memory");
    f32x4 ay[4][2];
    zero_acc(ay);
    gemm_acc<4, 2, false, true>(ay, ocb, 1024, Pt, Kb, Kb, lds, nullptr);
#pragma unroll
    for (int a = 0; a < 4; ++a)
#pragma unroll
        for (int b = 0; b < 2; ++b) {
            const float m0 = __uint_as_float(mgp[a][b][0] << 16) + __uint_as_float(gp[a][b][0] << 16) * ay[a][b][0];
            const float m1 = __uint_as_float(mgp[a][b][0] & 0xffff0000u) + __uint_as_float(gp[a][b][0] & 0xffff0000u) * ay[a][b][1];
            const float m2 = __uint_as_float(mgp[a][b][1] << 16) + __uint_as_float(gp[a][b][1] << 16) * ay[a][b][2];
            const float m3 = __uint_as_float(mgp[a][b][1] & 0xffff0000u) + __uint_as_float(gp[a][b][1] & 0xffff0000u) * ay[a][b][3];
            mgp[a][b][0] = pack2(m0, m1); mgp[a][b][1] = pack2(m2, m3);
        }
    asm volatile("" ::: "memory");
}
DEV void phase_merge(const Params& p, int l, char* lds) {
    const u16* xb = (const u16*)(WS(p) + OFF_XB);
    const u16* W = (const u16*)(WS(p) + OFF_W) + (size_t)l * WL_ELEMS;
    const u16* oc = (const u16*)(WS(p) + OFF_OCAT);
    u16* mrg = (u16*)(WS(p) + OFF_MRG);
    for (int it = blockIdx.x; it < 640 * 16; it += gridDim.x) {
        const int mi = it >> 4, ni = it & 15, m0 = mi * 128, n0 = ni * 64;
        u32x2 mgp[4][2];
#pragma unroll
        for (int a = 0; a < 4; ++a) { mgp[a][0] = (u32x2){0u, 0u}; mgp[a][1] = (u32x2){0u, 0u}; }
        const u16* xbt = xb + (size_t)m0 * 1024;
        const u16* ocb = oc + (size_t)m0 * 1024;
        merge_branch(mgp, xbt, W + W_WG + (size_t)(0 * 1024 + n0) * 1024, ocb + 0, W + W_RWP + (size_t)n0 * 256, 256, lds);
        merge_branch(mgp, xbt, W + W_WG + (size_t)(1 * 1024 + n0) * 1024, ocb + 256, W + W_MLAP + (size_t)n0 * 512, 512, lds);
        merge_branch(mgp, xbt, W + W_WG + (size_t)(2 * 1024 + n0) * 1024, ocb + 768, W + W_S5P + (size_t)n0 * 256, 256, lds);
        const int lane = TID() & 63, wid = TID() >> 6, wr = wid >> 1, wc = wid & 1, fr = lane & 15, g = lane >> 4;
#pragma unroll
        for (int mt = 0; mt < 4; ++mt)
#pragma unroll
            for (int nt = 0; nt < 2; ++nt) {
                const int row = m0 + wr * 64 + mt * 16 + fr, col = n0 + wc * 32 + nt * 16 + g * 4;
                *(u32x2*)(mrg + (size_t)row * 1024 + col) = mgp[mt][nt];
            }
    }
}

DEV void phase_resid_gemm(const Params& p, const u16* A, int lda, const u16* Bt, int K, char* lds) {
    const u16* xb = (const u16*)(WS(p) + OFF_XB);
    const int lane = TID() & 63, wid = TID() >> 6, wr = wid >> 1, wc = wid & 1, fr = lane & 15, g = lane >> 4;
    for (int it = blockIdx.x; it < 640 * 8; it += gridDim.x) {
        const int mi = it >> 3, ni = it & 7, m0 = mi * 128, n0 = ni * 128;
        f32x4 acc[4][4]; zero_acc(acc);
        gemm_acc<4, 4, false, true>(acc, A + (size_t)m0 * lda, lda, Bt + (size_t)n0 * K, K, K, lds, nullptr);
#pragma unroll
        for (int mt = 0; mt < 4; ++mt) {
            const int row = m0 + wr * 64 + mt * 16 + fr;
#pragma unroll
            for (int nt = 0; nt < 4; ++nt) {
                const int col = n0 + wc * 64 + nt * 16 + g * 4;
                const u32x2 xv = *(const u32x2*)(xb + (size_t)row * 1024 + col);
                f32x4 o;
                o[0] = DN_ALPHA * __uint_as_float(xv[0] << 16) + acc[mt][nt][0]; o[1] = DN_ALPHA * __uint_as_float(xv[0] & 0xffff0000u) + acc[mt][nt][1];
                o[2] = DN_ALPHA * __uint_as_float(xv[1] << 16) + acc[mt][nt][2]; o[3] = DN_ALPHA * __uint_as_float(xv[1] & 0xffff0000u) + acc[mt][nt][3];
                *(f32x4*)(OUTP(p) + (size_t)row * 1024 + col) = o;
            }
        }
    }
}

DEV void phase_ffn1(const Params& p, int l, char* lds) {
    const u16* xb = (const u16*)(WS(p) + OFF_XB);
    const u16* W = (const u16*)(WS(p) + OFF_W) + (size_t)l * WL_ELEMS + W_W1;
    u16* hb = (u16*)(WS(p) + OFF_H);
    const int lane = TID() & 63, wid = TID() >> 6, wr = wid >> 1, wc = wid & 1, fr = lane & 15, g = lane >> 4;
    for (int it = blockIdx.x; it < 640 * 32; it += gridDim.x) {
        const int mi = it >> 5, ni = it & 31, m0 = mi * 128, n0 = ni * 128;
        f32x4 acc[4][4]; zero_acc(acc);
        gemm_acc<4, 4, false, true>(acc, xb + (size_t)m0 * 1024, 1024, W + (size_t)n0 * 1024, 1024, 1024, lds, nullptr);
#pragma unroll
        for (int mt = 0; mt < 4; ++mt) {
            const int row = m0 + wr * 64 + mt * 16 + fr;
#pragma unroll
            for (int nt = 0; nt < 4; ++nt) {
                const int col = n0 + wc * 64 + nt * 16 + g * 4;
                const float r0 = fmaxf(acc[mt][nt][0], 0.f), r1 = fmaxf(acc[mt][nt][1], 0.f), r2 = fmaxf(acc[mt][nt][2], 0.f), r3 = fmaxf(acc[mt][nt][3], 0.f);
                u32x2 o; o[0] = pack2(r0 * r0, r1 * r1); o[1] = pack2(r2 * r2, r3 * r3);
                *(u32x2*)(hb + (size_t)row * 4096 + col) = o;
            }
        }
    }
}

DEV void phase_ln(const Params& p, const float* gam, const float* bet, bool write_f32) {
    const int lane = TID() & 63, wid = TID() >> 6;
    u16* xb = (u16*)(WS(p) + OFF_XB);
    for (int row = blockIdx.x * 4 + wid; row < T_TOK; row += gridDim.x * 4) {
        float* rp = OUTP(p) + (size_t)row * 1024;
        float4 v[4];
        float s = 0.f;
#pragma unroll
        for (int i = 0; i < 4; ++i) { v[i] = *(const float4*)(rp + i * 256 + lane * 4); s += v[i].x + v[i].y + v[i].z + v[i].w; }
        const float mean = wave_sum(s) * (1.f / 1024.f);
        float q = 0.f;
#pragma unroll
        for (int i = 0; i < 4; ++i) { v[i].x -= mean; v[i].y -= mean; v[i].z -= mean; v[i].w -= mean; q += v[i].x * v[i].x + v[i].y * v[i].y + v[i].z * v[i].z + v[i].w * v[i].w; }
        const float rstd = rsqrtf(wave_sum(q) * (1.f / 1024.f) + 1e-5f);
#pragma unroll
        for (int i = 0; i < 4; ++i) {
            const int c = i * 256 + lane * 4;
            const float4 gg = *(const float4*)(gam + c), bb = *(const float4*)(bet + c);
            float4 o;
            o.x = v[i].x * rstd * gg.x + bb.x; o.y = v[i].y * rstd * gg.y + bb.y; o.z = v[i].z * rstd * gg.z + bb.z; o.w = v[i].w * rstd * gg.w + bb.w;
            if (write_f32) *(float4*)(rp + c) = o;
            uint2 ob; ob.x = pack2(o.x, o.y); ob.y = pack2(o.z, o.w);
            *(uint2*)(xb + (size_t)row * 1024 + c) = ob;
        }
    }
}

__device__ __forceinline__ void run_phase(const Params& p, int ph, char* lds, int* s_item, int rep) {
    if (ph == 0) { phase_prologue(p, lds); return; }
    const int l = (ph - 1) / 10, sub = (ph - 1) % 10;
    const u16* Wl = (const u16*)(WS(p) + OFF_W) + (size_t)l * WL_ELEMS;
    switch (sub) {
    case 0: phase_zgemm(p, l, lds); break;
    case 1: {
        for (int it = blockIdx.x; it < 15680; it += gridDim.x) {
            if (it < 3840) mla_q_tile(p, l, it, lds);
            else if (it < 8960) mla_kv_tile(p, l, it - 3840, lds);
            else if (it < 14080) rwkv_prep_item(p, l, it - 8960, lds);
            else if (it < 15360) s5_passA(p, l, it - 14080);
            else krope_item(p, it - 15360);
        }
    } break;
    case 2: {
        int* ctr = (int*)(p.ws + OFF_CTR) + l + 2 * rep;
        for (;;) {
            __syncthreads();
            if (TID() == 0) *s_item = atomicAdd(ctr, 1);
            __syncthreads();
            const int it = *s_item;
            if (it >= 96 + 1280 + 5120) break;
#ifdef P3PART
            if (rep) {
                if (it < 96) { if (P3PART == 1) rwkv_scan_unit(p, l, it, lds, 1); }
                else if (it < 1376) { if (P3PART == 3) s5_passC(p, l, it - 96, lds); }
                else { if (P3PART == 2) attn_item(p, it - 1376, lds); }
                continue;
            }
#endif
            if (it < 96) rwkv_scan_unit(p, l, it, lds);
            else if (it < 1376) s5_passC(p, l, it - 96, lds);
            else attn_item(p, it - 1376, lds);
        }
    } break;
    case 3: {
        for (int it = blockIdx.x; it < 5120 + 1280; it += gridDim.x) {
            if (it < 5120) rwkv_post_item(p, l, it, lds);
            else s5_glu_tile(p, l, it - 5120, lds);
        }
    } break;
    case 4: phase_merge(p, l, lds); break;
    case 5: phase_resid_gemm(p, (const u16*)(WS(p) + OFF_MRG), 1024, Wl + W_WOUT, 1024, lds); break;
    case 6: phase_ln(p, p.in[32] + l * 1024, p.in[33] + l * 1024, false); break;
    case 7: phase_ffn1(p, l, lds); break;
    case 8: phase_resid_gemm(p, (const u16*)(WS(p) + OFF_H), 4096, Wl + W_W2, 4096, lds); break;
    case 9: phase_ln(p, p.in[36] + l * 1024, p.in[37] + l * 1024, true); break;
    }
}

__global__ void __launch_bounds__(256, 2) mega(Params p, int ph_lo, int ph_hi) {
    extern __shared__ __attribute__((aligned(16))) char lds[];
    __shared__ int s_item;
    cg::grid_group grid = cg::this_grid();
    for (int ph = ph_lo; ph < ph_hi; ++ph) {
        if (ph > ph_lo) grid.sync();
        int nrep = 1;
#ifdef REPEAT_SUB
        if (ph > 0 && (ph - 1) % 10 == REPEAT_SUB) nrep = 2;
#endif
        for (int r = 0; r < nrep; ++r) { if (r) grid.sync(); run_phase(p, ph, lds, &s_item, r); }
    }
}

extern "C" void kernel_launch(void* const* d_in, const int* in_sizes, int n_in, void* d_out, int out_size, void* d_ws, size_t ws_size,
                              hipStream_t stream) {
    static int grid_blocks = 0;
    if (!grid_blocks) {
        int dev = 0, cus = 0, per_cu = 0;
        hipGetDevice(&dev);
        hipDeviceGetAttribute(&cus, hipDeviceAttributeMultiprocessorCount, dev);
        hipFuncSetAttribute((const void*)mega, hipFuncAttributeMaxDynamicSharedMemorySize, LDS_BYTES);
        hipOccupancyMaxActiveBlocksPerMultiprocessor(&per_cu, mega, 256, LDS_BYTES);
        if (per_cu < 1) per_cu = 1;
        if (per_cu > 2) per_cu = 2;
        grid_blocks = cus * per_cu;
    }
    if (ws_size < OFF_END || n_in < 38) { fprintf(stderr, "workspace too small: %zu < %zu\n", ws_size, (size_t)OFF_END); return; }
    Params p{};
    for (int i = 0; i < 38; ++i) p.in[i] = (const float*)d_in[i];
    p.out = (float*)d_out;
    p.ws = (char*)d_ws;
#if ONE_LAUNCH
    int lo = 0, hi = 21;
    void* args[] = {&p, &lo, &hi};
    hipError_t e = hipLaunchCooperativeKernel((const void*)mega, dim3(grid_blocks), dim3(256), args, LDS_BYTES, stream);
    if (e != hipSuccess) fprintf(stderr, "cooperative launch failed: %s (grid %d)\n", hipGetErrorString(e), grid_blocks);
#else
    for (int ph = 0; ph < 21; ++ph) mega<<<dim3(grid_blocks), dim3(256), LDS_BYTES, stream>>>(p, ph, ph + 1);
#endif
}
```

```cpp
#include <hip/hip_runtime.h>
#include <hip/hip_cooperative_groups.h>
#include <hip/hip_fp16.h>
#include <cstdio>
#include <cstdint>
namespace cg = cooperative_groups;

#ifndef ONE_LAUNCH
#define ONE_LAUNCH 1
#endif

#ifndef SCANVAR
#define SCANVAR 0
#endif
typedef unsigned short u16;
typedef short bf16x8 __attribute__((ext_vector_type(8)));
typedef float f32x4 __attribute__((ext_vector_type(4)));
typedef unsigned u32x4 __attribute__((ext_vector_type(4)));
typedef unsigned u32x2 __attribute__((ext_vector_type(2)));
typedef float f32x2 __attribute__((ext_vector_type(2)));
#define DEV __device__ __forceinline__

constexpr int T_TOK = 81920;
constexpr int T_PROMPT = 65536;
constexpr float DN_ALPHA = 1.41421356237f;
constexpr int LDS_BYTES = 74752;

constexpr size_t OFF_CTR  = 0;
constexpr size_t OFF_ROPE = 65536;
constexpr size_t OFF_S5A  = OFF_ROPE + 1048576;
constexpr size_t OFF_S5BB = OFF_S5A + 32768;
constexpr size_t OFF_S5E  = OFF_S5BB + 524288;
constexpr size_t OFF_W    = OFF_S5E + 5242880;
constexpr size_t WL_ELEMS = 15728640;
constexpr size_t OFF_XB   = OFF_W + 2 * WL_ELEMS * 2;
constexpr size_t OFF_ZRW  = OFF_XB + (size_t)T_TOK * 1024 * 2;
constexpr size_t OFF_ZMLA = OFF_ZRW + (size_t)T_TOK * 896 * 2;
constexpr size_t OFF_YG   = OFF_ZMLA;
constexpr size_t OFF_ZS5  = OFF_ZMLA + (size_t)T_TOK * 416 * 2;
constexpr size_t OFF_Q    = OFF_ZS5 + (size_t)T_TOK * 256 * 2;
constexpr size_t OFF_MRG  = OFF_Q;
constexpr size_t OFF_K    = OFF_Q + (size_t)T_TOK * 768 * 2;
constexpr size_t OFF_KR   = OFF_K + (size_t)T_TOK * 512 * 2;
constexpr size_t OFF_VT   = OFF_KR + (size_t)T_TOK * 32 * 2;
constexpr size_t OFF_OCAT = OFF_VT + (size_t)T_TOK * 512 * 2;
constexpr size_t OFF_OFB  = OFF_OCAT + (size_t)T_TOK * 1024 * 2;
constexpr size_t OFF_END  = OFF_OFB + (size_t)2 * T_TOK * 256 * 2;
constexpr size_t OFF_H    = OFF_ZRW;
constexpr size_t W_WIN = 0, W_WG = 1703936, W_RWP = 4849664, W_MLAP = 5111808, W_S5P = 5636096, W_WOUT = 5898240,
                 W_W1 = 6946816, W_W2 = 11141120, W_WUQ = 15335424, W_WUKV = 15532032, W_GLU = 15663104;

struct Params { const float* in[38]; float* out; char* ws; };
__device__ __forceinline__ int TID() { int t = threadIdx.x; asm volatile("" : "+v"(t)); return t; }
typedef char __attribute__((address_space(1))) gchar_t;
typedef float __attribute__((address_space(1))) gfloat_t;
__device__ __forceinline__ char* WS(const Params& p) { gchar_t* w = (gchar_t*)p.ws; asm volatile("" : "+s"(w)); return (char*)w; }
__device__ __forceinline__ float* OUTP(const Params& p) { gfloat_t* w = (gfloat_t*)p.out; asm volatile("" : "+s"(w)); return (float*)w; }

DEV float bf2f(u16 h) { return __uint_as_float(((unsigned)h) << 16); }
typedef __bf16 bf16_2 __attribute__((ext_vector_type(2)));
DEV unsigned pack2(float a, float b) { bf16_2 v; v[0] = (__bf16)a; v[1] = (__bf16)b; return __builtin_bit_cast(unsigned, v); }
DEV u16 f2bf(float f) { return __builtin_bit_cast(u16, (__bf16)f); }
template <int CTRL> DEV float dppf(float v) { return __int_as_float(__builtin_amdgcn_update_dpp(0, __float_as_int(v), CTRL, 0xf, 0xf, false)); }
DEV float xsum16(float v) { auto r = __builtin_amdgcn_permlane16_swap(__float_as_uint(v), __float_as_uint(v), false, false); return __uint_as_float(r[0]) + __uint_as_float(r[1]); }
DEV float xsum32(float v) { auto r = __builtin_amdgcn_permlane32_swap(__float_as_uint(v), __float_as_uint(v), false, false); return __uint_as_float(r[0]) + __uint_as_float(r[1]); }
DEV float wave_sum(float v) {
    v += dppf<0xB1>(v); v += dppf<0x4E>(v); v += dppf<0x141>(v); v += dppf<0x140>(v);
    v = xsum16(v); v = xsum32(v);
    return v;
}
DEV float sigm(float x) { return __builtin_amdgcn_rcpf(1.f + __expf(-x)); }
DEV int tok_pos(int t) { return t < T_PROMPT ? (t & 8191) : (t & 4095); }
DEV int tok_len(int t) { return t < T_PROMPT ? 8192 : 4096; }

DEV void lds_barrier() { asm volatile("s_waitcnt lgkmcnt(0)\n\ts_barrier" ::: "memory"); }
template <int MT, int NT, bool ROWSS, bool TR>
DEV void gemm_acc(f32x4 (&acc)[MT][NT], const u16* __restrict__ A, int lda, const u16* __restrict__ Bt, int ldb, int K,
                  char* lds, float* ss_lds) {
    constexpr int BM = 32 * MT, BN = 32 * NT, PITCH = 128, STAGE = (BM + BN) * PITCH;
    const int tid = TID(), lane = tid & 63, wid = tid >> 6, wr = wid >> 1, wc = wid & 1, fr = lane & 15, g = lane >> 4;
    const int lrow = tid >> 3, lch = tid & 7;
    u32x4 ra0[MT], rb0[NT], ra1[MT], rb1[NT];
    float ss[MT];
#pragma unroll
    for (int i = 0; i < MT; ++i) ss[i] = 0.f;
    const u16* Ap = A + (size_t)lrow * lda + lch * 8;
    const u16* Bp = Bt + (size_t)lrow * ldb + lch * 8;
    const int nk = K >> 6;
    char* const wA = lds + lrow * PITCH + ((lch ^ ((lrow >> 1) & 7)) * 16);
    char* const wB = wA + BM * PITCH;
    const int rc0 = (g ^ (fr >> 1)) * 16, rc1 = ((4 + g) ^ (fr >> 1)) * 16;
    const char* const rA = lds + (wr * MT * 16 + fr) * PITCH;
    const char* const rB = lds + BM * PITCH + (wc * NT * 16 + fr) * PITCH;
#define GA_LOAD(RA, RB, KT) do { const int k0_ = (KT) * 64; \
        _Pragma("unroll") for (int i = 0; i < MT; ++i) RA[i] = *(const u32x4*)(Ap + (size_t)(32 * i) * lda + k0_); \
        _Pragma("unroll") for (int i = 0; i < NT; ++i) RB[i] = *(const u32x4*)(Bp + (size_t)(32 * i) * ldb + k0_); } while (0)
#define GA_STORE(RA, RB, ST) do { \
        _Pragma("unroll") for (int i = 0; i < MT; ++i) { *(u32x4*)(wA + (ST) * STAGE + (32 * i) * PITCH) = RA[i]; \
            if (ROWSS) { _Pragma("unroll") for (int q = 0; q < 4; ++q) { const unsigned wq = RA[i][q]; const float a_ = __uint_as_float(wq << 16), b_ = __uint_as_float(wq & 0xffff0000u); ss[i] += a_ * a_ + b_ * b_; } } } \
        _Pragma("unroll") for (int i = 0; i < NT; ++i) *(u32x4*)(wB + (ST) * STAGE + (32 * i) * PITCH) = RB[i]; } while (0)
#define GA_COMPUTE(ST) do { _Pragma("unroll") for (int ks = 0; ks < 2; ++ks) { bf16x8 af[MT], bfr[NT]; \
        _Pragma("unroll") for (int mt = 0; mt < MT; ++mt) af[mt] = *(const bf16x8*)(rA + (ST) * STAGE + (mt * 16) * PITCH + (ks ? rc1 : rc0)); \
        _Pragma("unroll") for (int nt = 0; nt < NT; ++nt) bfr[nt] = *(const bf16x8*)(rB + (ST) * STAGE + (nt * 16) * PITCH + (ks ? rc1 : rc0)); \
        _Pragma("unroll") for (int mt = 0; mt < MT; ++mt) _Pragma("unroll") for (int nt = 0; nt < NT; ++nt) \
            acc[mt][nt] = TR ? __builtin_amdgcn_mfma_f32_16x16x32_bf16(bfr[nt], af[mt], acc[mt][nt], 0, 0, 0) \
                             : __builtin_amdgcn_mfma_f32_16x16x32_bf16(af[mt], bfr[nt], acc[mt][nt], 0, 0, 0); } } while (0)
    __syncthreads();
    GA_LOAD(ra0, rb0, 0);
    GA_LOAD(ra1, rb1, 1);
    GA_STORE(ra0, rb0, 0);
    lds_barrier();
    for (int kt = 0; kt < nk; kt += 2) {
        if (kt + 2 < nk) GA_LOAD(ra0, rb0, kt + 2);
        GA_COMPUTE(0);
        GA_STORE(ra1, rb1, 1);
        lds_barrier();
        if (kt + 3 < nk) GA_LOAD(ra1, rb1, kt + 3);
        GA_COMPUTE(1);
        if (kt + 2 < nk) GA_STORE(ra0, rb0, 0);
        lds_barrier();
    }
#undef GA_LOAD
#undef GA_STORE
#undef GA_COMPUTE
    if (ROWSS) {
#pragma unroll
        for (int i = 0; i < MT; ++i) {
            float s_ = ss[i];
            s_ += __shfl_xor(s_, 1); s_ += __shfl_xor(s_, 2); s_ += __shfl_xor(s_, 4);
            if (lch == 0) ss_lds[lrow + 32 * i] = s_;
        }
        __syncthreads();
    }
}

template <int MT, int NT>
DEV void zero_acc(f32x4 (&acc)[MT][NT]) {
#pragma unroll
    for (int a = 0; a < MT; ++a)
#pragma unroll
        for (int b = 0; b < NT; ++b) acc[a][b] = (f32x4){0.f, 0.f, 0.f, 0.f};
}

DEV void tconv(u16* dst, const float* src, int K, int ld, int noff, int nvalid, int ntotal, const float* scale, char* lds) {
    float* tile = (float*)lds;
    const int tid = TID(), tx = tid & 63, ty = tid >> 6;
    const int ntn = ntotal >> 6, ntk = K >> 6;
    for (int t = blockIdx.x; t < ntn * ntk; t += gridDim.x) {
        const int tn = t % ntn, tk = t / ntn, n0 = tn * 64, k0 = tk * 64;
        __syncthreads();
#pragma unroll 4
        for (int r = ty; r < 64; r += 4) {
            const int n = n0 + tx, k = k0 + r;
            float v = 0.f;
            if (n < nvalid) { v = src[(size_t)k * ld + noff + n]; if (scale) v *= scale[k]; }
            tile[r * 65 + tx] = v;
        }
        __syncthreads();
#pragma unroll 4
        for (int r = ty; r < 64; r += 4)
            dst[(size_t)(n0 + r) * K + k0 + tx] = f2bf(tile[tx * 65 + r]);
    }
}

DEV void phase_prologue(const Params& p, char* lds) {
    const size_t gtid = (size_t)blockIdx.x * 256 + TID(), gsz = (size_t)gridDim.x * 256;
    if (gtid < 64) ((int*)(WS(p) + OFF_CTR))[gtid] = 0;
    u16* xb = (u16*)(WS(p) + OFF_XB);
    for (size_t i = gtid; i < (size_t)T_TOK * 256; i += gsz) {
        const size_t e = i * 4;
        const float* src = e < (size_t)T_PROMPT * 1024 ? p.in[0] + e : p.in[1] + (e - (size_t)T_PROMPT * 1024);
        const float4 v = *(const float4*)src;
        uint2 o; o.x = pack2(v.x, v.y); o.y = pack2(v.z, v.w);
        *(uint2*)(xb + e) = o;
    }
    for (int l = 0; l < 2; ++l) {
        u16* W = (u16*)(WS(p) + OFF_W) + (size_t)l * WL_ELEMS;
        tconv(W + W_WIN, p.in[2] + (size_t)l * 1024 * 4640, 1024, 4640, 0, 1568, 1664, nullptr, lds);
        tconv(W + W_WG, p.in[2] + (size_t)l * 1024 * 4640, 1024, 4640, 1568, 3072, 3072, nullptr, lds);
        tconv(W + W_RWP, p.in[14] + (size_t)l * 256 * 1024, 256, 1024, 0, 1024, 1024, nullptr, lds);
        tconv(W + W_MLAP, p.in[19] + (size_t)l * 512 * 1024, 512, 1024, 0, 1024, 1024, nullptr, lds);
        tconv(W + W_S5P, p.in[30] + (size_t)l * 256 * 1024, 256, 1024, 0, 1024, 1024, nullptr, lds);
        tconv(W + W_WOUT, p.in[31] + (size_t)l * 1024 * 1024, 1024, 1024, 0, 1024, 1024, nullptr, lds);
        tconv(W + W_W1, p.in[34] + (size_t)l * 1024 * 4096, 1024, 4096, 0, 4096, 4096, nullptr, lds);
        tconv(W + W_W2, p.in[35] + (size_t)l * 4096 * 1024, 4096, 1024, 0, 1024, 1024, nullptr, lds);
        tconv(W + W_WUQ, p.in[16] + (size_t)l * 256 * 768, 256, 768, 0, 768, 768, p.in[15] + l * 256, lds);
        tconv(W + W_WUKV, p.in[18] + (size_t)l * 128 * 1024, 128, 1024, 0, 1024, 1024, p.in[17] + l * 128, lds);
        tconv(W + W_GLU, p.in[28] + (size_t)l * 256 * 256, 256, 256, 0, 256, 256, nullptr, lds);
    }
    float2* rope = (float2*)(WS(p) + OFF_ROPE);
    for (size_t i = gtid; i < 8192 * 16; i += gsz) {
        const int pos = (int)(i >> 4), j = (int)(i & 15);
        const float inv = __builtin_amdgcn_exp2f(-(float)j * 0.830482023721841f);
        double rev = (double)pos * (double)inv * 0.15915494309189535;
        rev -= floor(rev);
        const float f = (float)rev;
        rope[i] = make_float2(__builtin_amdgcn_cosf(f), __builtin_amdgcn_sinf(f));
    }
    float2* s5a = (float2*)(WS(p) + OFF_S5A);
    float2* s5bb = (float2*)(WS(p) + OFF_S5BB);
    for (size_t i = gtid; i < 4096; i += gsz) {
        const int ldg = (int)(i >> 6);
        const float dt = __expf(p.in[22][ldg]);
        const float lr = p.in[20][i], li = p.in[21][i];
        const float zr = lr * dt, zi = li * dt;
        const float em = expm1f(zr);
        float rv = zi * 0.15915494309189535f; rv -= floorf(rv);
        float rh = 0.5f * zi * 0.15915494309189535f; rh -= floorf(rh);
        const float cz = __builtin_amdgcn_cosf(rv), sz = __builtin_amdgcn_sinf(rv), sh = __builtin_amdgcn_sinf(rh);
        const float are = (em + 1.f) * cz, aim = (em + 1.f) * sz;
        const float nr = em * cz - 2.f * sh * sh, ni = aim;
        const float den = lr * lr + li * li;
        const float cre = (nr * lr + ni * li) / den, cim = (ni * lr - nr * li) / den;
        s5a[i] = make_float2(are, aim);
        for (int c = 0; c < 16; ++c) {
            const float br = p.in[23][i * 16 + c], bi = p.in[24][i * 16 + c];
            s5bb[i * 16 + c] = make_float2(cre * br - cim * bi, cre * bi + cim * br);
        }
    }
}

DEV void phase_zgemm(const Params& p, int l, char* lds) {
    const u16* xb = (const u16*)(WS(p) + OFF_XB);
    const u16* W = (const u16*)(WS(p) + OFF_W) + (size_t)l * WL_ELEMS + W_WIN;
    u16* zrw = (u16*)(WS(p) + OFF_ZRW); u16* zmla = (u16*)(WS(p) + OFF_ZMLA); u16* zs5 = (u16*)(WS(p) + OFF_ZS5);
    const int lane = TID() & 63, wid = TID() >> 6, wr = wid >> 1, wc = wid & 1, fr = lane & 15, g = lane >> 4;
    for (int it = blockIdx.x; it < 640 * 13; it += gridDim.x) {
        const int mi = it / 13, ni = it % 13, m0 = mi * 128, n0 = ni * 128;
        f32x4 acc[4][4]; zero_acc(acc);
        gemm_acc<4, 4, false, true>(acc, xb + (size_t)m0 * 1024, 1024, W + (size_t)n0 * 1024, 1024, 1024, lds, nullptr);
#pragma unroll
        for (int nt = 0; nt < 4; ++nt) {
            const int c0 = n0 + wc * 64 + nt * 16;
            u16* dst; int ld, cc;
            if (c0 < 896) { dst = zrw; ld = 896; cc = c0; }
            else if (c0 < 1312) { dst = zmla; ld = 416; cc = c0 - 896; }
            else if (c0 < 1568) { dst = zs5; ld = 256; cc = c0 - 1312; }
            else continue;
#pragma unroll
            for (int mt = 0; mt < 4; ++mt) {
                const int row = m0 + wr * 64 + mt * 16 + fr;
                u32x2 o; o[0] = pack2(acc[mt][nt][0], acc[mt][nt][1]); o[1] = pack2(acc[mt][nt][2], acc[mt][nt][3]);
                *(u32x2*)(dst + (size_t)row * ld + cc + g * 4) = o;
            }
        }
    }
}

DEV void load_zraw(const u16* zrw, int t0, char* lds) {
    const int pos0 = tok_pos(t0), L = tok_len(t0);
    for (int id = TID(); id < 18 * 112; id += 256) {
        const int r = id / 112, ch = id % 112, pos = pos0 - 1 + r;
        uint4 v = make_uint4(0, 0, 0, 0);
        if (pos >= 0 && pos < L) v = *(const uint4*)(zrw + (size_t)(t0 - 1 + r) * 896 + ch * 8);
        *(uint4*)(lds + r * 1792 + ch * 16) = v;
    }
}
DEV float zshift(const u16* zr, const float* mu, int tl, int col) {
    const float z = bf2f(zr[(tl + 1) * 896 + col]), zm = bf2f(zr[tl * 896 + col]), zp = bf2f(zr[(tl + 2) * 896 + col]);
    return z + mu[col] * (0.5f * (zm + zp) - z);
}

DEV void rwkv_prep_item(const Params& p, int l, int item, char* lds) {
    const int t0 = item * 16, c = TID();
    const u16* zrw = (const u16*)(WS(p) + OFF_ZRW);
    __syncthreads();
    load_zraw(zrw, t0, lds);
    __syncthreads();
    const u16* zr = (const u16*)lds;
    float* act = (float*)(lds + 32768);
    const float* mu = p.in[3] + l * 896;
    for (int id = c; id < 16 * 64; id += 256) {
        const int tl = id >> 6, j = id & 63;
        const float v = zshift(zr, mu, tl, 768 + j);
        act[tl * 64 + j] = j < 32 ? tanhf(v) : v;
    }
    __syncthreads();
    const float* w2 = p.in[5] + (size_t)l * 16384;
    const float* a2 = p.in[7] + (size_t)l * 16384;
    const float w00 = p.in[4][l * 512 + c], w01 = p.in[4][l * 512 + 256 + c];
    const float a00 = p.in[6][l * 512 + c], a01 = p.in[6][l * 512 + 256 + c];
    const float kkc = p.in[9][l * 256 + c];
    __half* comp = (__half*)OUTP(p);
#pragma unroll 1
    for (int th = 0; th < 2; ++th) {
        float wp0[8], wp1[8], ap0[8], ap1[8];
#pragma unroll
        for (int t = 0; t < 8; ++t) { wp0[t] = 0.f; wp1[t] = 0.f; ap0[t] = 0.f; ap1[t] = 0.f; }
        const float* actb = act + th * 8 * 64;
#pragma unroll 2
        for (int k4 = 0; k4 < 8; ++k4) {
            float w20[4], w21[4], a20[4], a21[4];
#pragma unroll
            for (int i = 0; i < 4; ++i) {
                const int k = k4 * 4 + i;
                w20[i] = w2[k * 256 + c]; w21[i] = w2[8192 + k * 256 + c]; a20[i] = a2[k * 256 + c]; a21[i] = a2[8192 + k * 256 + c];
            }
#pragma unroll
            for (int t = 0; t < 8; ++t) {
                const f32x4 xw = *(const f32x4*)(actb + t * 64 + k4 * 4), xa = *(const f32x4*)(actb + t * 64 + 32 + k4 * 4);
#pragma unroll
                for (int i = 0; i < 4; ++i) { wp0[t] += xw[i] * w20[i]; wp1[t] += xw[i] * w21[i]; ap0[t] += xa[i] * a20[i]; ap1[t] += xa[i] * a21[i]; }
            }
        }
#pragma unroll
        for (int t = 0; t < 8; ++t) {
            const int tl = th * 8 + t;
            const float r = zshift(zr, mu, tl, c), k = zshift(zr, mu, tl, 256 + c), v = zshift(zr, mu, tl, 512 + c);
            const float kr = k * kkc;
            const float ssum = wave_sum(kr * kr);
            const float kkn = kr * rsqrtf(fmaxf(ssum, 1e-12f));
            const float ew0 = 0.60653066f * sigm(w00 + wp0[t]), ew1 = 0.60653066f * sigm(w01 + wp1[t]);
            const float av0 = sigm(a00 + ap0[t]), av1 = sigm(a01 + ap1[t]);
            __half* row = comp + (size_t)(t0 + tl) * 2048;
            row[c] = __float2half(kkn); row[256 + c] = __float2half(r); row[512 + c] = __float2half(k); row[768 + c] = __float2half(v);
            row[1024 + c] = __float2half(ew0); row[1280 + c] = __float2half(ew1); row[1536 + c] = __float2half(av0); row[1792 + c] = __float2half(av1);
        }
    }
}

DEV void unpack16(const uint4 a, const uint4 b, float (&u)[16]) {
    const unsigned w[8] = {a.x, a.y, a.z, a.w, b.x, b.y, b.z, b.w};
#pragma unroll
    for (int i = 0; i < 8; ++i) { u[2 * i] = __uint_as_float(w[i] << 16); u[2 * i + 1] = __uint_as_float(w[i] & 0xffff0000u); }
}

DEV void s5_passA(const Params& p, int l, int item) {
    const int lane = TID() & 63, w = TID() >> 6;
    const int ci = item >> 2, g = (item & 3) * 4 + w, t0 = ci * 256;
    const u16* zs5 = (const u16*)(WS(p) + OFF_ZS5);
    const float2* s5a = (const float2*)(WS(p) + OFF_S5A);
    const float2* s5bb = (const float2*)(WS(p) + OFF_S5BB);
    float2* E = (float2*)(WS(p) + OFF_S5E);
    for (int d = 0; d < 2; ++d) {
        const int pi = ((l * 2 + d) * 16 + g) * 64 + lane;
        const float2 a = s5a[pi];
        float2 bb[16];
#pragma unroll
        for (int c = 0; c < 16; ++c) bb[c] = s5bb[(size_t)pi * 16 + c];
        float xr = 0.f, xi = 0.f;
        for (int n = 0; n < 256; ++n) {
            const int t = d ? t0 + 255 - n : t0 + n;
            const uint4* up = (const uint4*)(zs5 + (size_t)t * 256 + g * 16);
            float u[16]; unpack16(up[0], up[1], u);
            float br = 0.f, bi = 0.f;
#pragma unroll
            for (int c = 0; c < 16; ++c) { br += u[c] * bb[c].x; bi += u[c] * bb[c].y; }
            const float nr = a.x * xr - a.y * xi + br, ni = a.x * xi + a.y * xr + bi;
            xr = nr; xi = ni;
        }
        E[(size_t)((ci * 16 + g) * 2 + d) * 64 + lane] = make_float2(xr, xi);
    }
}

DEV float gelu_tanh(float y) { return 0.5f * y * (1.f + tanhf(0.7978845608f * (y + 0.044715f * y * y * y))); }

DEV void s5_passC(const Params& p, int l, int item, char* lds) {
    const int lane = TID() & 63, w = TID() >> 6, fr = lane & 15, gq = lane >> 4;
    const int ci = item >> 2, g = (item & 3) * 4 + w, t0 = ci * 256;
    const int pos0 = tok_pos(t0), L = tok_len(t0), s0 = t0 - pos0;
    const int kc = pos0 >> 8, nck = L >> 8, ci0 = s0 >> 8;
    const u16* zs5 = (const u16*)(WS(p) + OFF_ZS5);
    u16* yg = (u16*)(WS(p) + OFF_YG);
    const float2* s5a = (const float2*)(WS(p) + OFF_S5A);
    const float2* s5bb = (const float2*)(WS(p) + OFF_S5BB);
    const float2* E = (const float2*)(WS(p) + OFF_S5E);
    u16* Xs = (u16*)(lds + w * 4352);
    const float dsk = p.in[27][l * 256 + g * 16 + fr];
    __syncthreads();
    for (int d = 0; d < 2; ++d) {
        const int pi = ((l * 2 + d) * 16 + g) * 64 + lane;
        const float2 a = s5a[pi];
        float2 bb[16];
#pragma unroll
        for (int c = 0; c < 16; ++c) bb[c] = s5bb[(size_t)pi * 16 + c];
        float2 aP = a;
#pragma unroll
        for (int i = 0; i < 8; ++i) aP = make_float2(aP.x * aP.x - aP.y * aP.y, 2.f * aP.x * aP.y);
        float xr = 0.f, xi = 0.f;
        if (d == 0) {
            for (int k2 = 0; k2 < kc; ++k2) {
                const float2 e = E[(size_t)(((ci0 + k2) * 16 + g) * 2 + 0) * 64 + lane];
                const float nr = aP.x * xr - aP.y * xi + e.x, ni = aP.x * xi + aP.y * xr + e.y; xr = nr; xi = ni;
            }
        } else {
            for (int k2 = nck - 1; k2 > kc; --k2) {
                const float2 e = E[(size_t)(((ci0 + k2) * 16 + g) * 2 + 1) * 64 + lane];
                const float nr = aP.x * xr - aP.y * xi + e.x, ni = aP.x * xi + aP.y * xr + e.y; xr = nr; xi = ni;
            }
        }
        bf16x8 cf[4];
        const float* cre = p.in[25] + (size_t)(((l * 2 + d) * 16 + g) * 16 + fr) * 64;
        const float* cim = p.in[26] + (size_t)(((l * 2 + d) * 16 + g) * 16 + fr) * 64;
#pragma unroll
        for (int ks = 0; ks < 4; ++ks)
#pragma unroll
            for (int e = 0; e < 8; ++e) {
                const int k = ks * 32 + gq * 8 + e, pp = k >> 1;
                const float v = (k & 1) ? -cim[pp] : cre[pp];
                cf[ks][e] = (short)f2bf(v);
            }
        for (int sc = 0; sc < 16; ++sc) {
            const int tb = d ? t0 + 240 - sc * 16 : t0 + sc * 16;
            for (int s = 0; s < 16; ++s) {
                const int tl = d ? 15 - s : s, t = tb + tl;
                const uint4* up = (const uint4*)(zs5 + (size_t)t * 256 + g * 16);
                float u[16]; unpack16(up[0], up[1], u);
                float br = 0.f, bi = 0.f;
#pragma unroll
                for (int c = 0; c < 16; ++c) { br += u[c] * bb[c].x; bi += u[c] * bb[c].y; }
                const float nr = a.x * xr - a.y * xi + br, ni = a.x * xi + a.y * xr + bi;
                xr = nr; xi = ni;
                *(unsigned*)(Xs + tl * 136 + lane * 2) = pack2(xr, xi);
            }
            __builtin_amdgcn_fence(__ATOMIC_RELEASE, "wavefront");
            __builtin_amdgcn_wave_barrier();
            asm volatile("s_waitcnt lgkmcnt(0)" ::: "memory");
            f32x4 y = (f32x4){0.f, 0.f, 0.f, 0.f};
#pragma unroll
            for (int ks = 0; ks < 4; ++ks) {
                const bf16x8 xa = *(const bf16x8*)(Xs + fr * 136 + ks * 32 + gq * 8);
                y = __builtin_amdgcn_mfma_f32_16x16x32_bf16(xa, cf[ks], y, 0, 0, 0);
            }
            asm volatile("s_waitcnt lgkmcnt(0)" ::: "memory");
            __builtin_amdgcn_wave_barrier();
#pragma unroll
            for (int e = 0; e < 4; ++e) {
                const int t = tb + gq * 4 + e;
                const size_t idx = (size_t)t * 256 + g * 16 + fr;
                if (d == 0) yg[idx] = f2bf(y[e]);
                else {
                    const float uu = bf2f(zs5[idx]);
                    const float yy = bf2f(yg[idx]) + y[e] + dsk * uu;
                    yg[idx] = f2bf(gelu_tanh(yy));
                }
            }
        }
    }
}

DEV void krope_item(const Params& p, int item) {
    const u16* zmla = (const u16*)(WS(p) + OFF_ZMLA);
    u16* kr = (u16*)(WS(p) + OFF_KR);
    const float2* rope = (const float2*)(WS(p) + OFF_ROPE);
    const int t0 = item * 256;
    for (int id = TID(); id < 4096; id += 256) {
        const int t = t0 + (id >> 4), j = id & 15, pos = tok_pos(t);
        const float z1 = bf2f(zmla[(size_t)t * 416 + 384 + j]), z2 = bf2f(zmla[(size_t)t * 416 + 400 + j]);
        const float2 cs = rope[pos * 16 + j];
        kr[(size_t)t * 32 + j] = f2bf(z1 * cs.x - z2 * cs.y);
        kr[(size_t)t * 32 + 16 + j] = f2bf(z1 * cs.y + z2 * cs.x);
    }
}

DEV void mla_q_tile(const Params& p, int l, int it, char* lds) {
    const int mi = it / 6, ni = it % 6, m0 = mi * 128, n0 = ni * 128;
    const u16* zmla = (const u16*)(WS(p) + OFF_ZMLA);
    const u16* W = (const u16*)(WS(p) + OFF_W) + (size_t)l * WL_ELEMS + W_WUQ;
    u16* q = (u16*)(WS(p) + OFF_Q);
    const float2* rope = (const float2*)(WS(p) + OFF_ROPE);
    float* ssl = (float*)(lds + 73728);
    const int lane = TID() & 63, wid = TID() >> 6, wr = wid >> 1, wc = wid & 1, fr = lane & 15, g = lane >> 4;
    f32x4 acc[4][4]; zero_acc(acc);
    gemm_acc<4, 4, true, true>(acc, zmla + (size_t)m0 * 416, 416, W + (size_t)n0 * 256, 256, 256, lds, ssl);
    const float QS = 0.10206207261596577f * 1.4426950408889634f;
#pragma unroll
    for (int mt = 0; mt < 4; ++mt) {
        const int rl = wr * 64 + mt * 16 + fr, row = m0 + rl;
        const float rs = rsqrtf(ssl[rl] * (1.f / 256.f) + 1e-6f) * QS;
        const float2* cp = rope + tok_pos(row) * 16 + g * 4;
        u16* qrow = q + (size_t)row * 768 + n0 + wc * 64 + g * 4;
#pragma unroll
        for (int nt = 0; nt < 4; nt += 2) {
            const int c0 = n0 + wc * 64 + nt * 16;
            f32x4 v0 = acc[mt][nt] * rs, v1 = acc[mt][nt + 1] * rs;
            if ((c0 % 96) == 64) {
#pragma unroll
                for (int e = 0; e < 4; ++e) {
                    const float2 cs = cp[e];
                    const float t1 = v0[e], t2 = v1[e];
                    v0[e] = t1 * cs.x - t2 * cs.y; v1[e] = t1 * cs.y + t2 * cs.x;
                }
            }
            u32x2 o0, o1; o0[0] = pack2(v0[0], v0[1]); o0[1] = pack2(v0[2], v0[3]); o1[0] = pack2(v1[0], v1[1]); o1[1] = pack2(v1[2], v1[3]);
            *(u32x2*)(qrow + nt * 16) = o0;
            *(u32x2*)(qrow + nt * 16 + 16) = o1;
        }
        asm volatile("" ::: "memory");
    }
}

DEV void mla_kv_tile(const Params& p, int l, int it, char* lds) {
    const int mi = it >> 3, h = it & 7, m0 = mi * 128;
    const u16* zmla = (const u16*)(WS(p) + OFF_ZMLA);
    const u16* W = (const u16*)(WS(p) + OFF_W) + (size_t)l * WL_ELEMS + W_WUKV;
    u16* kb = (u16*)(WS(p) + OFF_K);
    u16* vT = (u16*)(WS(p) + OFF_VT);
    float* ssl = (float*)(lds + 73728);
    const int lane = TID() & 63, wid = TID() >> 6, wr = wid >> 1, wc = wid & 1, fr = lane & 15, g = lane >> 4;
    f32x4 acc[4][4]; zero_acc(acc);
    gemm_acc<4, 4, true, false>(acc, zmla + (size_t)m0 * 416 + 256, 416, W + (size_t)(h * 128) * 128, 128, 128, lds, ssl);
    const int pos0 = tok_pos(m0), L = tok_len(m0), s0 = m0 - pos0;
#pragma unroll
    for (int mt = 0; mt < 4; ++mt) {
        const int rl0 = wr * 64 + mt * 16 + g * 4;
        float rs[4];
#pragma unroll
        for (int e = 0; e < 4; ++e) rs[e] = rsqrtf(ssl[rl0 + e] * (1.f / 128.f) + 1e-6f);
#pragma unroll
        for (int nt = 0; nt < 4; ++nt) {
            const int cw = nt * 16 + fr;
            if (wc == 0) {
#pragma unroll
                for (int e = 0; e < 4; ++e) kb[(size_t)(m0 + rl0 + e) * 512 + h * 64 + cw] = f2bf(acc[mt][nt][e] * rs[e]);
            } else {
                uint2 o; o.x = pack2(acc[mt][nt][0] * rs[0], acc[mt][nt][1] * rs[1]); o.y = pack2(acc[mt][nt][2] * rs[2], acc[mt][nt][3] * rs[3]);
                *(uint2*)(vT + (size_t)s0 * 512 + (size_t)(h * 64 + cw) * L + pos0 + rl0) = o;
            }
        }
    }
}

DEV float bcast_row0(float x) {
    auto r = __builtin_amdgcn_permlane16_swap(__float_as_uint(x), __float_as_uint(x), false, false);
    auto q = __builtin_amdgcn_permlane32_swap(r[0], r[0], false, false);
    return __uint_as_float(q[0]);
}
DEV void rwkv_scan_unit(const Params& p, int l, int unit, char* lds, int rep = 0) {
    int seq, h, dir;
    if (unit < 64) { seq = unit >> 3; h = (unit >> 1) & 3; dir = unit & 1; }
    else { const int u = unit - 64; seq = 8 + (u >> 3); h = (u >> 1) & 3; dir = u & 1; }
    const int L = seq < 8 ? 8192 : 4096, s0 = seq < 8 ? seq * 8192 : T_PROMPT + (seq - 8) * 4096;
    const int tid = TID(), lane = tid & 63, w = tid >> 6, il = lane & 15, g = lane >> 4;
    float* opf = (float*)lds;
    u16* opa = (u16*)(opf + 32 * 2 * 64);
    float* vs = (float*)(opa + 32 * 4 * 64);
    float* cc = vs + 32 * 64;
    float* gc = cc + 64;
    float* tot = gc + 64;
    float* obuf = tot + 256;
    f32x2 S2[8];
#pragma unroll
    for (int j = 0; j < 8; ++j) S2[j] = (f32x2){0.f, 0.f};
    const __half* comp = (const __half*)OUTP(p);
    const float ka = p.in[10][l * 256 + h * 64 + lane];
    u16* ob = (u16*)(WS(p) + OFF_OFB) + (size_t)dir * T_TOK * 256;
    const int nch = L / 32;
    __half hkk[8], hr[8], hk[8], hv[8], hew[8], ha[8];
#pragma unroll
    for (int s = 0; s < 8; ++s) {
        const int n = w * 8 + s, pos = dir ? L - 1 - n : n;
        const __half* row = comp + (size_t)(s0 + pos) * 2048 + h * 64 + lane;
        hkk[s] = row[0]; hr[s] = row[256]; hk[s] = row[512]; hv[s] = row[768]; hew[s] = row[1024 + dir * 256]; ha[s] = row[1536 + dir * 256];
    }
    lds_barrier();
    for (int ch = 0; ch < nch; ++ch) {
        float ew[8], cum[8], kkv[8], rv[8], kv[8], av[8];
        float run = 0.f;
#pragma unroll
        for (int s = 0; s < 8; ++s) {
            kkv[s] = __half2float(hkk[s]); rv[s] = __half2float(hr[s]); kv[s] = __half2float(hk[s]);
            ew[s] = __half2float(hew[s]); av[s] = __half2float(ha[s]);
            vs[(w * 8 + s) * 64 + lane] = __half2float(hv[s]);
            run += ew[s]; cum[s] = run;
        }
        tot[w * 64 + lane] = run;
        if (ch + 1 < nch) {
#pragma unroll
            for (int s = 0; s < 8; ++s) {
                const int n = (ch + 1) * 32 + w * 8 + s, pos = dir ? L - 1 - n : n;
                const __half* row = comp + (size_t)(s0 + pos) * 2048 + h * 64 + lane;
                hkk[s] = row[0]; hr[s] = row[256]; hk[s] = row[512]; hv[s] = row[768]; hew[s] = row[1024 + dir * 256]; ha[s] = row[1536 + dir * 256];
            }
        }
        lds_barrier();
        float off = 0.f;
#pragma unroll
        for (int w2 = 0; w2 < 3; ++w2) if (w2 < w) off += tot[w2 * 64 + lane];
        if (w == 0) gc[lane] = __expf(-(tot[lane] + tot[64 + lane] + tot[128 + lane] + tot[192 + lane]));
#pragma unroll
        for (int s = 0; s < 8; ++s) {
            const float ct = off + cum[s], cp = ct - ew[s];
            const float Gt = __expf(-ct), Gp = __expf(-cp), iG = __expf(ct);
            const float b = kkv[s] * av[s], kd = kv[s] * (1.f + (av[s] - 1.f) * ka);
            const int sl = w * 8 + s;
            const float kt = kkv[s] * Gp, rt = rv[s] * Gt;
            const u16 kth = f2bf(kt), rth = f2bf(rt);
            opa[(sl * 4 + 0) * 64 + lane] = kth;
            opa[(sl * 4 + 1) * 64 + lane] = rth;
            opa[(sl * 4 + 2) * 64 + lane] = f2bf(kt - bf2f(kth));
            opa[(sl * 4 + 3) * 64 + lane] = f2bf(rt - bf2f(rth));
            opf[(sl * 2 + 0) * 64 + lane] = b * iG;
            opf[(sl * 2 + 1) * 64 + lane] = kd * iG;
            const float c1 = wave_sum(b * rv[s]), c2 = wave_sum(kd * rv[s]);
            if (lane == 0) { cc[sl * 2] = c1; cc[sl * 2 + 1] = c2; }
        }
        lds_barrier();
        const int aoff = (lane & 3) * 64 + g * 8;
        bf16x8 a0 = *(const bf16x8*)(opa + aoff), a1 = *(const bf16x8*)(opa + aoff + 32);
        for (int sl = 0; sl < ((SCANVAR == 3 && rep) ? 0 : 32); ++sl) {
            union { bf16x8 v; unsigned u[4]; } b0, b1;
#pragma unroll
            for (int q = 0; q < 4; ++q) { b0.u[q] = pack2(S2[q].x, S2[q].y); b1.u[q] = pack2(S2[4 + q].x, S2[4 + q].y); }
            f32x4 D = (f32x4){0.f, 0.f, 0.f, 0.f};
            D = __builtin_amdgcn_mfma_f32_16x16x32_bf16(a0, b0.v, D, 0, 0, 0);
            D = __builtin_amdgcn_mfma_f32_16x16x32_bf16(a1, b1.v, D, 0, 0, 0);
            const f32x4* f4 = (const f32x4*)(opf + sl * 128);
            f32x4 BH[4], KH[4];
            if (SCANVAR == 2 && rep) { const f32x4 cst = (f32x4){1e-3f, 2e-3f, 1e-3f, 3e-3f};
                BH[0] = cst; BH[1] = cst; BH[2] = cst; BH[3] = cst; KH[0] = cst; KH[1] = cst; KH[2] = cst; KH[3] = cst; }
            else {
            BH[0] = f4[g * 2]; BH[1] = f4[g * 2 + 1]; BH[2] = f4[8 + g * 2]; BH[3] = f4[8 + g * 2 + 1];
            KH[0] = f4[16 + g * 2]; KH[1] = f4[16 + g * 2 + 1]; KH[2] = f4[24 + g * 2]; KH[3] = f4[24 + g * 2 + 1]; }
            const float v = vs[sl * 64 + w * 16 + il];
            const float c1 = cc[sl * 2], c2 = cc[sl * 2 + 1];
            {
                const u16* na = opa + (sl < 31 ? sl + 1 : 31) * 256 + aoff;
                a0 = *(const bf16x8*)na; a1 = *(const bf16x8*)(na + 32);
            }
            const float u = D[0] + D[2], o1 = D[1] + D[3];
            obuf[sl * 64 + w * 16 + il] = o1 - u * c1 + v * c2;
            const f32x2 vv2 = (f32x2){v, v}, nu2 = (f32x2){-u, -u};
#pragma unroll
            for (int q = 0; q < 4; ++q) {
                S2[2 * q] = __builtin_elementwise_fma(vv2, (f32x2){KH[q][0], KH[q][1]}, __builtin_elementwise_fma(nu2, (f32x2){BH[q][0], BH[q][1]}, S2[2 * q]));
                S2[2 * q + 1] = __builtin_elementwise_fma(vv2, (f32x2){KH[q][2], KH[q][3]}, __builtin_elementwise_fma(nu2, (f32x2){BH[q][2], BH[q][3]}, S2[2 * q + 1]));
            }
        }
#pragma unroll
        for (int q = 0; q < 4; ++q) {
            S2[q] *= *(const f32x2*)(gc + g * 8 + 2 * q);
            S2[4 + q] *= *(const f32x2*)(gc + 32 + g * 8 + 2 * q);
        }
        lds_barrier();
        if (!rep)
#pragma unroll
        for (int i = 0; i < 8; ++i) {
            const int idx = tid + i * 256, sl = idx >> 6, c = idx & 63;
            const int n = ch * 32 + sl, pos = dir ? L - 1 - n : n;
            ob[(size_t)(s0 + pos) * 256 + h * 64 + c] = f2bf(obuf[idx]);
        }
    }
    lds_barrier();
}

DEV void attn_item(const Params& p, int item, char* lds) {
    int seq, h, qt;
    if (item < 4096) { seq = item >> 9; const int r = item & 511; h = r >> 6; qt = r & 63; }
    else { int r = item - 4096; seq = 8 + (r >> 8); r &= 255; h = r >> 5; qt = r & 31; }
    const int L = seq < 8 ? 8192 : 4096, s0 = seq < 8 ? seq * 8192 : T_PROMPT + (seq - 8) * 4096;
    const int tid = TID(), lane = tid & 63, wid = tid >> 6, fr = lane & 15, g = lane >> 4;
    const int q0 = s0 + qt * 128 + wid * 32;
    const u16* qb = (const u16*)(WS(p) + OFF_Q);
    const u16* kb = (const u16*)(WS(p) + OFF_K) + (size_t)s0 * 512 + h * 64;
    const u16* krb = (const u16*)(WS(p) + OFF_KR) + (size_t)s0 * 32;
    const u16* vb = (const u16*)(WS(p) + OFF_VT) + (size_t)s0 * 512 + (size_t)h * 64 * L;
    u16* oc = (u16*)(WS(p) + OFF_OCAT);
    constexpr int KP = 208, VP = 144, VOFF = 64 * KP, ASTAGE = VOFF + 64 * VP;
    bf16x8 qf[2][3];
#pragma unroll
    for (int nt = 0; nt < 2; ++nt)
#pragma unroll
        for (int ks = 0; ks < 3; ++ks) qf[nt][ks] = *(const bf16x8*)(qb + (size_t)(q0 + nt * 16 + fr) * 768 + h * 96 + ks * 32 + g * 8);
    f32x4 oT[4][2];
#pragma unroll
    for (int a = 0; a < 4; ++a) { oT[a][0] = (f32x4){0.f, 0.f, 0.f, 0.f}; oT[a][1] = (f32x4){0.f, 0.f, 0.f, 0.f}; }
    float mrow[2] = {-1e30f, -1e30f}, lsum[2] = {0.f, 0.f};
    const int krow = tid >> 3, kch = tid & 7, rrow = tid >> 2, rch = tid & 3;
    u32x4 rk0, rk1, rkr, rv0, rv1;
    const int ntile = L / 64;
    __syncthreads();
    {
        rk0 = *(const u32x4*)(kb + (size_t)krow * 512 + kch * 8);
        rk1 = *(const u32x4*)(kb + (size_t)(krow + 32) * 512 + kch * 8);
        rkr = *(const u32x4*)(krb + (size_t)rrow * 32 + rch * 8);
        rv0 = *(const u32x4*)(vb + (size_t)krow * L + kch * 8);
        rv1 = *(const u32x4*)(vb + (size_t)(krow + 32) * L + kch * 8);
    }
    for (int kt = 0; kt < ntile; ++kt) {
        char* st = lds + (kt & 1) * ASTAGE;
        *(u32x4*)(st + krow * KP + kch * 16) = rk0;
        *(u32x4*)(st + (krow + 32) * KP + kch * 16) = rk1;
        *(u32x4*)(st + rrow * KP + 128 + rch * 16) = rkr;
        *(u32x4*)(st + VOFF + krow * VP + kch * 16) = rv0;
        *(u32x4*)(st + VOFF + (krow + 32) * VP + kch * 16) = rv1;
        __syncthreads();
        if (kt + 1 < ntile) {
            const int key0 = (kt + 1) * 64;
            rk0 = *(const u32x4*)(kb + (size_t)(key0 + krow) * 512 + kch * 8);
            rk1 = *(const u32x4*)(kb + (size_t)(key0 + krow + 32) * 512 + kch * 8);
            rkr = *(const u32x4*)(krb + (size_t)(key0 + rrow) * 32 + rch * 8);
            rv0 = *(const u32x4*)(vb + (size_t)krow * L + key0 + kch * 8);
            rv1 = *(const u32x4*)(vb + (size_t)(krow + 32) * L + key0 + kch * 8);
        }
        f32x4 sc[4][2];
#pragma unroll
        for (int a = 0; a < 4; ++a) { sc[a][0] = (f32x4){0.f, 0.f, 0.f, 0.f}; sc[a][1] = (f32x4){0.f, 0.f, 0.f, 0.f}; }
#pragma unroll
        for (int ks = 0; ks < 3; ++ks) {
            bf16x8 kf[4];
#pragma unroll
            for (int mt = 0; mt < 4; ++mt) kf[mt] = *(const bf16x8*)(st + (mt * 16 + fr) * KP + (ks * 4 + g) * 16);
#pragma unroll
            for (int mt = 0; mt < 4; ++mt)
#pragma unroll
                for (int nt = 0; nt < 2; ++nt) sc[mt][nt] = __builtin_amdgcn_mfma_f32_16x16x32_bf16(kf[mt], qf[nt][ks], sc[mt][nt], 0, 0, 0);
        }
        bf16x8 pb[2][2];
#pragma unroll
        for (int nt = 0; nt < 2; ++nt) {
            float mx = -1e30f;
#pragma unroll
            for (int mt = 0; mt < 4; ++mt)
#pragma unroll
                for (int e = 0; e < 4; ++e) mx = fmaxf(mx, sc[mt][nt][e]);
            mx = fmaxf(mx, __shfl_xor(mx, 16)); mx = fmaxf(mx, __shfl_xor(mx, 32));
            const float mn = fmaxf(mrow[nt], mx);
            const float al = __builtin_amdgcn_exp2f(mrow[nt] - mn);
            mrow[nt] = mn;
            float rs = 0.f;
#pragma unroll
            for (int mt = 0; mt < 4; ++mt)
#pragma unroll
                for (int e = 0; e < 4; ++e) { const float pv = __builtin_amdgcn_exp2f(sc[mt][nt][e] - mn); sc[mt][nt][e] = pv; rs += pv; }
            lsum[nt] = lsum[nt] * al + rs;
#pragma unroll
            for (int a = 0; a < 4; ++a) oT[a][nt] *= al;
#pragma unroll
            for (int s = 0; s < 2; ++s) {
                union { bf16x8 v; unsigned u[4]; } pk;
                pk.u[0] = pack2(sc[2 * s][nt][0], sc[2 * s][nt][1]); pk.u[1] = pack2(sc[2 * s][nt][2], sc[2 * s][nt][3]);
                pk.u[2] = pack2(sc[2 * s + 1][nt][0], sc[2 * s + 1][nt][1]); pk.u[3] = pack2(sc[2 * s + 1][nt][2], sc[2 * s + 1][nt][3]);
                pb[nt][s] = pk.v;
            }
        }
#pragma unroll
        for (int s = 0; s < 2; ++s)
#pragma unroll
            for (int dvt = 0; dvt < 4; ++dvt) {
                const char* vp = st + VOFF + (dvt * 16 + fr) * VP + (32 * s + 4 * g) * 2;
                union { bf16x8 v; u32x2 u[2]; } vf;
                vf.u[0] = *(const u32x2*)vp; vf.u[1] = *(const u32x2*)(vp + 32);
#pragma unroll
                for (int nt = 0; nt < 2; ++nt) oT[dvt][nt] = __builtin_amdgcn_mfma_f32_16x16x32_bf16(vf.v, pb[nt][s], oT[dvt][nt], 0, 0, 0);
            }
    }
#pragma unroll
    for (int nt = 0; nt < 2; ++nt) {
        float lt = lsum[nt];
        lt += __shfl_xor(lt, 16); lt += __shfl_xor(lt, 32);
        const float inv = 1.f / lt;
        const int tok = q0 + nt * 16 + fr;
#pragma unroll
        for (int dvt = 0; dvt < 4; ++dvt) {
            uint2 o; o.x = pack2(oT[dvt][nt][0] * inv, oT[dvt][nt][1] * inv); o.y = pack2(oT[dvt][nt][2] * inv, oT[dvt][nt][3] * inv);
            *(uint2*)(oc + (size_t)tok * 1024 + 256 + h * 64 + dvt * 16 + g * 4) = o;
        }
    }
}

DEV void rwkv_post_item(const Params& p, int l, int item, char* lds) {
    const int t0 = item * 16, c = TID();
    const u16* zrw = (const u16*)(WS(p) + OFF_ZRW);
    __syncthreads();
    load_zraw(zrw, t0, lds);
    __syncthreads();
    const u16* zr = (const u16*)lds;
    float* act = (float*)(lds + 32768);
    const float* mu = p.in[3] + l * 896;
    for (int id = c; id < 16 * 64; id += 256) {
        const int tl = id >> 6, j = id & 63;
        act[tl * 64 + j] = sigm(zshift(zr, mu, tl, 832 + j));
    }
    __syncthreads();
    const float* g2 = p.in[8] + (size_t)l * 16384;
    const float gng = p.in[12][l * 256 + c], gnb = p.in[13][l * 256 + c], rk = p.in[11][l * 256 + c];
    const u16* of = (const u16*)(WS(p) + OFF_OFB);
    const u16* obk = of + (size_t)T_TOK * 256;
    u16* oc = (u16*)(WS(p) + OFF_OCAT);
#pragma unroll 1
    for (int th = 0; th < 2; ++th) {
        float ga[8];
#pragma unroll
        for (int t = 0; t < 8; ++t) ga[t] = 0.f;
        const float* actb = act + th * 8 * 64;
#pragma unroll 4
        for (int k4 = 0; k4 < 16; ++k4) {
            float gw[4];
#pragma unroll
            for (int i = 0; i < 4; ++i) gw[i] = g2[(k4 * 4 + i) * 256 + c];
#pragma unroll
            for (int t = 0; t < 8; ++t) {
                const f32x4 xg = *(const f32x4*)(actb + t * 64 + k4 * 4);
#pragma unroll
                for (int i = 0; i < 4; ++i) ga[t] += xg[i] * gw[i];
            }
        }
#pragma unroll
        for (int t = 0; t < 8; ++t) {
            const int tl = th * 8 + t;
            const float r = zshift(zr, mu, tl, c), k = zshift(zr, mu, tl, 256 + c), v = zshift(zr, mu, tl, 512 + c);
            const float o = bf2f(of[(size_t)(t0 + tl) * 256 + c]) + bf2f(obk[(size_t)(t0 + tl) * 256 + c]);
            const float mean = wave_sum(o) * (1.f / 64.f), dlt = o - mean;
            const float var = wave_sum(dlt * dlt) * (1.f / 64.f);
            const float on = dlt * rsqrtf(var + 64e-5f) * gng + gnb;
            const float bonus = wave_sum(r * k * rk) * v;
            oc[(size_t)(t0 + tl) * 1024 + c] = f2bf((on + bonus) * ga[t]);
        }
    }
}

DEV void s5_glu_tile(const Params& p, int l, int it, char* lds) {
    const int mi = it >> 1, ni = it & 1, m0 = mi * 128, n0 = ni * 128;
    const u16* yg = (const u16*)(WS(p) + OFF_YG);
    const u16* W = (const u16*)(WS(p) + OFF_W) + (size_t)l * WL_ELEMS + W_GLU;
    u16* oc = (u16*)(WS(p) + OFF_OCAT);
    const float* gb = p.in[29] + l * 256;
    const int lane = TID() & 63, wid = TID() >> 6, wr = wid >> 1, wc = wid & 1, fr = lane & 15, g = lane >> 4;
    f32x4 acc[4][4]; zero_acc(acc);
    gemm_acc<4, 4, false, true>(acc, yg + (size_t)m0 * 256, 256, W + (size_t)n0 * 256, 256, 256, lds, nullptr);
#pragma unroll
    for (int nt = 0; nt < 4; ++nt) {
        const int col = n0 + wc * 64 + nt * 16 + g * 4;
        const f32x4 bias = *(const f32x4*)(gb + col);
#pragma unroll
        for (int mt = 0; mt < 4; ++mt) {
            const int row = m0 + wr * 64 + mt * 16 + fr;
            const u32x2 yv = *(const u32x2*)(yg + (size_t)row * 256 + col);
            const float y0 = __uint_as_float(yv[0] << 16), y1 = __uint_as_float(yv[0] & 0xffff0000u), y2 = __uint_as_float(yv[1] << 16), y3 = __uint_as_float(yv[1] & 0xffff0000u);
            u32x2 o; o[0] = pack2(y0 * sigm(acc[mt][nt][0] + bias[0]), y1 * sigm(acc[mt][nt][1] + bias[1]));
            o[1] = pack2(y2 * sigm(acc[mt][nt][2] + bias[2]), y3 * sigm(acc[mt][nt][3] + bias[3]));
            *(u32x2*)(oc + (size_t)row * 1024 + 768 + col) = o;
        }
    }
}

DEV void merge_branch(u32x2 (&mgp)[4][2], const u16* xbt, const u16* Wg, const u16* ocb, const u16* Pt, int Kb, char* lds) {
    u32x2 gp[4][2];
    {
        f32x4 ag[4][2];
        zero_acc(ag);
        gemm_acc<4, 2, false, true>(ag, xbt, 1024, Wg, 1024, 1024, lds, nullptr);
#pragma unroll
        for (int a = 0; a < 4; ++a)
#pragma unroll
            for (int b = 0; b < 2; ++b) {
                gp[a][b][0] = pack2(sigm(ag[a][b][0]), sigm(ag[a][b][1]));
                gp[a][b][1] = pack2(sigm(ag[a][b][2]), sigm(ag[a][b][3]));
            }
    }
    asm volatile("" ::: "memory");
    f32x4 ay[4][2];
    zero_acc(ay);
    gemm_acc<4, 2, false, true>(ay, ocb, 1024, Pt, Kb, Kb, lds, nullptr);
#pragma unroll
    for (int a = 0; a < 4; ++a)
#pragma unroll
        for (int b = 0; b < 2; ++b) {
            const float m0 = __uint_as_float(mgp[a][b][0] << 16) + __uint_as_float(gp[a][b][0] << 16) * ay[a][b][0];
            const float m1 = __uint_as_float(mgp[a][b][0] & 0xffff0000u) + __uint_as_float(gp[a][b][0] & 0xffff0000u) * ay[a][b][1];
            const float m2 = __uint_as_float(mgp[a][b][1] << 16) + __uint_as_float(gp[a][b][1] << 16) * ay[a][b][2];
            const float m3 = __uint_as_float(mgp[a][b][1] & 0xffff0000u) + __uint_as_float(gp[a][b][1] & 0xffff0000u) * ay[a][b][3];
            mgp[a][b][0] = pack2(m0, m1); mgp[a][b][1] = pack2(m2, m3);
        }
    asm volatile("" ::: "memory");
}
DEV void phase_merge(const Params& p, int l, char* lds) {
    const u16* xb = (const u16*)(WS(p) + OFF_XB);
    const u16* W = (const u16*)(WS(p) + OFF_W) + (size_t)l * WL_ELEMS;
    const u16* oc = (const u16*)(WS(p) + OFF_OCAT);
    u16* mrg = (u16*)(WS(p) + OFF_MRG);
    for (int it = blockIdx.x; it < 640 * 16; it += gridDim.x) {
        const int mi = it >> 4, ni = it & 15, m0 = mi * 128, n0 = ni * 64;
        u32x2 mgp[4][2];
#pragma unroll
        for (int a = 0; a < 4; ++a) { mgp[a][0] = (u32x2){0u, 0u}; mgp[a][1] = (u32x2){0u, 0u}; }
        const u16* xbt = xb + (size_t)m0 * 1024;
        const u16* ocb = oc + (size_t)m0 * 1024;
        merge_branch(mgp, xbt, W + W_WG + (size_t)(0 * 1024 + n0) * 1024, ocb + 0, W + W_RWP + (size_t)n0 * 256, 256, lds);
        merge_branch(mgp, xbt, W + W_WG + (size_t)(1 * 1024 + n0) * 1024, ocb + 256, W + W_MLAP + (size_t)n0 * 512, 512, lds);
        merge_branch(mgp, xbt, W + W_WG + (size_t)(2 * 1024 + n0) * 1024, ocb + 768, W + W_S5P + (size_t)n0 * 256, 256, lds);
        const int lane = TID() & 63, wid = TID() >> 6, wr = wid >> 1, wc = wid & 1, fr = lane & 15, g = lane >> 4;
#pragma unroll
        for (int mt = 0; mt < 4; ++mt)
#pragma unroll
            for (int nt = 0; nt < 2; ++nt) {
                const int row = m0 + wr * 64 + mt * 16 + fr, col = n0 + wc * 32 + nt * 16 + g * 4;
                *(u32x2*)(mrg + (size_t)row * 1024 + col) = mgp[mt][nt];
            }
    }
}

DEV void phase_resid_gemm(const Params& p, const u16* A, int lda, const u16* Bt, int K, char* lds) {
    const u16* xb = (const u16*)(WS(p) + OFF_XB);
    const int lane = TID() & 63, wid = TID() >> 6, wr = wid >> 1, wc = wid & 1, fr = lane & 15, g = lane >> 4;
    for (int it = blockIdx.x; it < 640 * 8; it += gridDim.x) {
        const int mi = it >> 3, ni = it & 7, m0 = mi * 128, n0 = ni * 128;
        f32x4 acc[4][4]; zero_acc(acc);
        gemm_acc<4, 4, false, true>(acc, A + (size_t)m0 * lda, lda, Bt + (size_t)n0 * K, K, K, lds, nullptr);
#pragma unroll
        for (int mt = 0; mt < 4; ++mt) {
            const int row = m0 + wr * 64 + mt * 16 + fr;
#pragma unroll
            for (int nt = 0; nt < 4; ++nt) {
                const int col = n0 + wc * 64 + nt * 16 + g * 4;
                const u32x2 xv = *(const u32x2*)(xb + (size_t)row * 1024 + col);
                f32x4 o;
                o[0] = DN_ALPHA * __uint_as_float(xv[0] << 16) + acc[mt][nt][0]; o[1] = DN_ALPHA * __uint_as_float(xv[0] & 0xffff0000u) + acc[mt][nt][1];
                o[2] = DN_ALPHA * __uint_as_float(xv[1] << 16) + acc[mt][nt][2]; o[3] = DN_ALPHA * __uint_as_float(xv[1] & 0xffff0000u) + acc[mt][nt][3];
                *(f32x4*)(OUTP(p) + (size_t)row * 1024 + col) = o;
            }
        }
    }
}

DEV void phase_ffn1(const Params& p, int l, char* lds) {
    const u16* xb = (const u16*)(WS(p) + OFF_XB);
    const u16* W = (const u16*)(WS(p) + OFF_W) + (size_t)l * WL_ELEMS + W_W1;
    u16* hb = (u16*)(WS(p) + OFF_H);
    const int lane = TID() & 63, wid = TID() >> 6, wr = wid >> 1, wc = wid & 1, fr = lane & 15, g = lane >> 4;
    for (int it = blockIdx.x; it < 640 * 32; it += gridDim.x) {
        const int mi = it >> 5, ni = it & 31, m0 = mi * 128, n0 = ni * 128;
        f32x4 acc[4][4]; zero_acc(acc);
        gemm_acc<4, 4, false, true>(acc, xb + (size_t)m0 * 1024, 1024, W + (size_t)n0 * 1024, 1024, 1024, lds, nullptr);
#pragma unroll
        for (int mt = 0; mt < 4; ++mt) {
            const int row = m0 + wr * 64 + mt * 16 + fr;
#pragma unroll
            for (int nt = 0; nt < 4; ++nt) {
                const int col = n0 + wc * 64 + nt * 16 + g * 4;
                const float r0 = fmaxf(acc[mt][nt][0], 0.f), r1 = fmaxf(acc[mt][nt][1], 0.f), r2 = fmaxf(acc[mt][nt][2], 0.f), r3 = fmaxf(acc[mt][nt][3], 0.f);
                u32x2 o; o[0] = pack2(r0 * r0, r1 * r1); o[1] = pack2(r2 * r2, r3 * r3);
                *(u32x2*)(hb + (size_t)row * 4096 + col) = o;
            }
        }
    }
}

DEV void phase_ln(const Params& p, const float* gam, const float* bet, bool write_f32, bool write_bf16) {
    const int lane = TID() & 63, wid = TID() >> 6;
    u16* xb = (u16*)(WS(p) + OFF_XB);
    for (int row = blockIdx.x * 4 + wid; row < T_TOK; row += gridDim.x * 4) {
        float* rp = OUTP(p) + (size_t)row * 1024;
        float4 v[4];
        float s = 0.f;
#pragma unroll
        for (int i = 0; i < 4; ++i) { v[i] = *(const float4*)(rp + i * 256 + lane * 4); s += v[i].x + v[i].y + v[i].z + v[i].w; }
        const float mean = wave_sum(s) * (1.f / 1024.f);
        float q = 0.f;
#pragma unroll
        for (int i = 0; i < 4; ++i) { v[i].x -= mean; v[i].y -= mean; v[i].z -= mean; v[i].w -= mean; q += v[i].x * v[i].x + v[i].y * v[i].y + v[i].z * v[i].z + v[i].w * v[i].w; }
        const float rstd = rsqrtf(wave_sum(q) * (1.f / 1024.f) + 1e-5f);
#pragma unroll
        for (int i = 0; i < 4; ++i) {
            const int c = i * 256 + lane * 4;
            const float4 gg = *(const float4*)(gam + c), bb = *(const float4*)(bet + c);
            float4 o;
            o.x = v[i].x * rstd * gg.x + bb.x; o.y = v[i].y * rstd * gg.y + bb.y; o.z = v[i].z * rstd * gg.z + bb.z; o.w = v[i].w * rstd * gg.w + bb.w;
            if (write_f32) *(float4*)(rp + c) = o;
            if (write_bf16) {
                uint2 ob; ob.x = pack2(o.x, o.y); ob.y = pack2(o.z, o.w);
                *(uint2*)(xb + (size_t)row * 1024 + c) = ob;
            }
        }
    }
}

__device__ __forceinline__ void run_phase(const Params& p, int ph, char* lds, int* s_item, int rep) {
    if (ph == 0) { phase_prologue(p, lds); return; }
    const int l = (ph - 1) / 10, sub = (ph - 1) % 10;
    const u16* Wl = (const u16*)(WS(p) + OFF_W) + (size_t)l * WL_ELEMS;
    switch (sub) {
    case 0: phase_zgemm(p, l, lds); break;
    case 1: {
        for (int it = blockIdx.x; it < 15680; it += gridDim.x) {
            if (it < 3840) mla_q_tile(p, l, it, lds);
            else if (it < 8960) mla_kv_tile(p, l, it - 3840, lds);
            else if (it < 14080) rwkv_prep_item(p, l, it - 8960, lds);
            else if (it < 15360) s5_passA(p, l, it - 14080);
            else krope_item(p, it - 15360);
        }
    } break;
    case 2: {
        int* ctr = (int*)(p.ws + OFF_CTR) + l + 2 * rep;
        for (;;) {
            __syncthreads();
            if (TID() == 0) *s_item = atomicAdd(ctr, 1);
            __syncthreads();
            const int it = *s_item;
            if (it >= 96 + 1280 + 5120) break;
#ifdef P3PART
            if (rep) {
                if (it < 96) { if (P3PART == 1) rwkv_scan_unit(p, l, it, lds, 1); }
                else if (it < 1376) { if (P3PART == 3) s5_passC(p, l, it - 96, lds); }
                else { if (P3PART == 2) attn_item(p, it - 1376, lds); }
                continue;
            }
#endif
            if (it < 96) rwkv_scan_unit(p, l, it, lds);
            else if (it < 1376) s5_passC(p, l, it - 96, lds);
            else attn_item(p, it - 1376, lds);
        }
    } break;
    case 3: {
        for (int it = blockIdx.x; it < 5120 + 1280; it += gridDim.x) {
            if (it < 5120) rwkv_post_item(p, l, it, lds);
            else s5_glu_tile(p, l, it - 5120, lds);
        }
    } break;
    case 4: phase_merge(p, l, lds); break;
    case 5: phase_resid_gemm(p, (const u16*)(WS(p) + OFF_MRG), 1024, Wl + W_WOUT, 1024, lds); break;
    case 6: phase_ln(p, p.in[32] + l * 1024, p.in[33] + l * 1024, false, true); break;
    case 7: phase_ffn1(p, l, lds); break;
    case 8: phase_resid_gemm(p, (const u16*)(WS(p) + OFF_H), 4096, Wl + W_W2, 4096, lds); break;
    case 9: phase_ln(p, p.in[36] + l * 1024, p.in[37] + l * 1024, true, l == 0); break;
    }
}

__global__ void __launch_bounds__(256, 2) mega(Params p, int ph_lo, int ph_hi) {
    extern __shared__ __attribute__((aligned(16))) char lds[];
    __shared__ int s_item;
    cg::grid_group grid = cg::this_grid();
    for (int ph = ph_lo; ph < ph_hi; ++ph) {
        if (ph > ph_lo) grid.sync();
        int nrep = 1;
#ifdef REPEAT_SUB
        if (ph > 0 && (ph - 1) % 10 == REPEAT_SUB) nrep = 2;
#endif
        for (int r = 0; r < nrep; ++r) { if (r) grid.sync(); run_phase(p, ph, lds, &s_item, r); }
    }
}

extern "C" void kernel_launch(void* const* d_in, const int* in_sizes, int n_in, void* d_out, int out_size, void* d_ws, size_t ws_size,
                              hipStream_t stream) {
    static int grid_blocks = 0;
    if (!grid_blocks) {
        int dev = 0, cus = 0, per_cu = 0;
        hipGetDevice(&dev);
        hipDeviceGetAttribute(&cus, hipDeviceAttributeMultiprocessorCount, dev);
        hipFuncSetAttribute((const void*)mega, hipFuncAttributeMaxDynamicSharedMemorySize, LDS_BYTES);
        hipOccupancyMaxActiveBlocksPerMultiprocessor(&per_cu, mega, 256, LDS_BYTES);
        if (per_cu < 1) per_cu = 1;
        if (per_cu > 2) per_cu = 2;
        grid_blocks = cus * per_cu;
    }
    if (ws_size < OFF_END || n_in < 38) { fprintf(stderr, "workspace too small: %zu < %zu\n", ws_size, (size_t)OFF_END); return; }
    Params p{};
    for (int i = 0; i < 38; ++i) p.in[i] = (const float*)d_in[i];
    p.out = (float*)d_out;
    p.ws = (char*)d_ws;
#if ONE_LAUNCH
    int lo = 0, hi = 21;
    void* args[] = {&p, &lo, &hi};
    hipError_t e = hipLaunchCooperativeKernel((const void*)mega, dim3(grid_blocks), dim3(256), args, LDS_BYTES, stream);
    if (e != hipSuccess) fprintf(stderr, "cooperative launch failed: %s (grid %d)\n", hipGetErrorString(e), grid_blocks);
#else
    for (int ph = 0; ph < 21; ++ph) mega<<<dim3(grid_blocks), dim3(256), LDS_BYTES, stream>>>(p, ph, ph + 1);
#endif
}
```
